# Optimizing an MI355X kernel written in HIP

```python
import math
import jax, jax.numpy as jnp
from jax import lax
import numpy as np

D_MODEL = 1024
BATCH = 16
SEQ = 2048
DEPTH = 1

D_MIX = D_MODEL
D_S5 = D_MIX // 2
S5_GROUP = 16
S5_GROUPS = D_S5 // S5_GROUP
S5_STATE = 64
D_GLA = D_MIX - D_S5
GLA_HEADS = 4
GLA_DK = D_GLA // 2 // GLA_HEADS
GLA_DV = D_GLA // GLA_HEADS
GLA_QK = GLA_HEADS * GLA_DK
GLA_LOWRANK = 16
GLA_TAU = 16.0
GLA_CHUNK = 64
D_IN_PROJ = D_S5 + 2 * GLA_QK + D_GLA + GLA_LOWRANK + D_GLA
N_EXPERTS = 256
TOP_K = 8
N_GROUPS = 8
TOPK_GROUPS = 4
D_EXPERT = 256
ROUTED_SCALE = 2.5
EXPERT_BLOCK = 128
EPS = 1e-6

kernel_name = 'hybrid_s5_gla_moe_block'


def rmsnorm(x, g):
    xf = x.astype(jnp.float32)
    r = lax.rsqrt(jnp.mean(xf * xf, axis=-1, keepdims=True) + EPS)
    return (xf * r).astype(x.dtype) * g


def modulate(h, shift, scale):
    return h * (1.0 + scale[:, None, :]) + shift[:, None, :]


def _cplx_scan_op(left, right):
    ar1, ai1, br1, bi1 = left
    ar2, ai2, br2, bi2 = right
    return (ar2 * ar1 - ai2 * ai1,
            ar2 * ai1 + ai2 * ar1,
            ar2 * br1 - ai2 * bi1 + br2,
            ar2 * bi1 + ai2 * br1 + bi2)


def s5_mixer(u, lam_re, lam_im, log_dt, b_re, b_im, c_re, c_im, d_skip, w_glu, b_glu, norm_g):
    bsz, L, _ = u.shape
    f32 = jnp.float32
    uf = u.astype(f32).reshape(bsz, L, S5_GROUPS, S5_GROUP)
    dt = jnp.exp(log_dt.astype(f32))[:, None]
    lr, li = lam_re.astype(f32), lam_im.astype(f32)
    mag = jnp.exp(lr * dt)
    ab_re, ab_im = mag * jnp.cos(li * dt), mag * jnp.sin(li * dt)
    den = lr * lr + li * li
    nr = ab_re - 1.0
    coef_re = ((nr * lr + ab_im * li) / den)[..., None]
    coef_im = ((ab_im * lr - nr * li) / den)[..., None]
    br, bi = b_re.astype(f32), b_im.astype(f32)
    bb_re = coef_re * br - coef_im * bi
    bb_im = coef_re * bi + coef_im * br
    bu_re = jnp.einsum('blgc,gnc->blgn', uf, bb_re)
    bu_im = jnp.einsum('blgc,gnc->blgn', uf, bb_im)
    a_re = jnp.broadcast_to(ab_re, bu_re.shape)
    a_im = jnp.broadcast_to(ab_im, bu_im.shape)
    _, _, h_re, h_im = lax.associative_scan(_cplx_scan_op, (a_re, a_im, bu_re, bu_im), axis=1)
    y = (jnp.einsum('blgn,gcn->blgc', h_re, c_re.astype(f32))
         - jnp.einsum('blgn,gcn->blgc', h_im, c_im.astype(f32))
         + d_skip.astype(f32) * uf)
    y = y.reshape(bsz, L, D_S5).astype(u.dtype)
    g = jax.nn.gelu(y)
    out = g * jax.nn.sigmoid(g @ w_glu + b_glu)
    return rmsnorm(out, norm_g)


def gla_mixer(q, k, v, glr, r, w_g2, b_g2, norm_g):
    bsz, L, _ = q.shape
    n, C = L // GLA_CHUNK, GLA_CHUNK
    f32 = jnp.float32
    qf = q.astype(f32).reshape(bsz, n, C, GLA_HEADS, GLA_DK) * (GLA_DK ** -0.5)
    kf = k.astype(f32).reshape(bsz, n, C, GLA_HEADS, GLA_DK)
    vf = v.astype(f32).reshape(bsz, n, C, GLA_HEADS, GLA_DV)
    log_a = jax.nn.log_sigmoid((glr @ w_g2 + b_g2).astype(f32)) / GLA_TAU
    log_a = log_a.reshape(bsz, n, C, GLA_HEADS, GLA_DK)
    bcum = jnp.cumsum(log_a, axis=2)
    b_last = bcum[:, :, -1]
    q_i = qf * jnp.exp(bcum)
    k_i = kf * jnp.exp(-bcum)
    mask = jnp.tril(jnp.ones((C, C), dtype=bool))
    scores = jnp.where(mask, jnp.einsum('bnchk,bnshk->bnhcs', q_i, k_i), 0.0)
    o_intra = jnp.einsum('bnhcs,bnshv->bnchv', scores, vf)
    k_dec = kf * jnp.exp(b_last[:, :, None] - bcum)
    kv = jnp.einsum('bnshk,bnshv->bnhkv', k_dec, vf)
    decay = jnp.exp(b_last)

    def step(S, inp):
        kv_n, dec_n = inp
        return dec_n[..., None] * S + kv_n, S

    S0 = jnp.zeros((bsz, GLA_HEADS, GLA_DK, GLA_DV), f32)
    _, S_prev = lax.scan(step, S0, (jnp.moveaxis(kv, 1, 0), jnp.moveaxis(decay, 1, 0)))
    S_prev = jnp.moveaxis(S_prev, 0, 1)
    o_inter = jnp.einsum('bnchk,bnhkv->bnchv', q_i, S_prev)
    o = (o_intra + o_inter).reshape(bsz, L, GLA_HEADS, GLA_DV)
    o = o * lax.rsqrt(jnp.mean(o * o, axis=-1, keepdims=True) + EPS)
    o = (o.astype(q.dtype) * norm_g).reshape(bsz, L, D_GLA)
    return o * jax.nn.silu(r)


def moe(h, w_router, e_bias, w_gate, w_up, w_down, ws_gate, ws_up, ws_down):
    bsz, L, D = h.shape
    T = bsz * L
    TK = T * TOP_K
    hf = h.reshape(T, D)
    scores = jax.nn.sigmoid((hf @ w_router).astype(jnp.float32))
    biased = scores + e_bias.astype(jnp.float32)
    per_group = N_EXPERTS // N_GROUPS
    grp_score = lax.top_k(biased.reshape(T, N_GROUPS, per_group), 2)[0].sum(-1)
    _, top_groups = lax.top_k(grp_score, TOPK_GROUPS)
    group_mask = jnp.any(top_groups[..., None] == jnp.arange(N_GROUPS)[None, None, :], axis=1)
    masked = jnp.where(jnp.repeat(group_mask, per_group, axis=-1), biased, -jnp.inf)
    _, top_e = lax.top_k(masked, TOP_K)
    sel = jnp.take_along_axis(scores, top_e, axis=-1)
    gates = sel / jnp.sum(sel, axis=-1, keepdims=True) * ROUTED_SCALE

    e_flat = top_e.reshape(TK).astype(jnp.int32)
    tok_flat = jnp.arange(TK, dtype=jnp.int32) // TOP_K
    g_flat = gates.reshape(TK)
    order = jnp.argsort(e_flat)
    e_sorted = e_flat[order]
    counts = jnp.zeros((N_EXPERTS,), jnp.int32).at[e_flat].add(1)
    padded = (counts + EXPERT_BLOCK - 1) // EXPERT_BLOCK * EXPERT_BLOCK
    starts = jnp.cumsum(counts) - counts
    pends = jnp.cumsum(padded)
    pstarts = pends - padded
    dest = pstarts[e_sorted] + (jnp.arange(TK, dtype=jnp.int32) - starts[e_sorted])
    n_blocks = (TK + N_EXPERTS * (EXPERT_BLOCK - 1) + EXPERT_BLOCK - 1) // EXPERT_BLOCK
    P = n_blocks * EXPERT_BLOCK
    slot_tok = jnp.full((P,), T, jnp.int32).at[dest].set(tok_flat[order])
    slot_gate = jnp.zeros((P,), h.dtype).at[dest].set(g_flat[order].astype(h.dtype))
    block_start = jnp.arange(n_blocks, dtype=jnp.int32) * EXPERT_BLOCK
    block_expert = jnp.minimum(jnp.searchsorted(pends, block_start, side='right'), N_EXPERTS - 1)
    x_pad = jnp.concatenate([hf, jnp.zeros((1, D), hf.dtype)], axis=0)

    def expert_block(args):
        idx, gb, e = args
        xb = x_pad[idx]
        hb = jax.nn.silu(xb @ w_gate[e]) * (xb @ w_up[e])
        return (hb @ w_down[e]) * gb[:, None]

    ys = lax.map(expert_block, (slot_tok.reshape(n_blocks, EXPERT_BLOCK),
                                slot_gate.reshape(n_blocks, EXPERT_BLOCK), block_expert))
    routed = jax.ops.segment_sum(ys.reshape(P, D), slot_tok, num_segments=T + 1)[:T]
    shared = (jax.nn.silu(hf @ ws_gate) * (hf @ ws_up)) @ ws_down
    return (routed + shared).reshape(bsz, L, D)


def setup_inputs(seed: int = 0) -> dict:
    key = jax.random.key(seed)
    ks = jax.random.split(key, 32)
    f32 = jnp.float32
    nrm = lambda k, shape, s: jax.random.normal(k, shape, f32) * s
    D, G, N = D_MODEL, S5_GROUPS, S5_STATE
    lam_im0 = jnp.pi * jnp.arange(N, dtype=f32)
    log_dt = jax.random.uniform(ks[6], (DEPTH, G), f32, math.log(0.001), math.log(0.1))
    return {
        'x': nrm(ks[0], (BATCH, SEQ, D), 1.0),
        'c': nrm(ks[1], (BATCH, D), 1.0),
        'w_ada': nrm(ks[2], (DEPTH, D, 6 * D), 0.5 * D ** -0.5),
        'b_ada': nrm(ks[3], (DEPTH, 6 * D), 0.02),
        'g_norm_mix': 1.0 + nrm(ks[4], (DEPTH, D), 0.02),
        'w_in': nrm(ks[5], (DEPTH, D, D_IN_PROJ), D ** -0.5),
        's5_lambda_re': -0.5 + nrm(ks[7], (DEPTH, G, N), 0.01),
        's5_lambda_im': lam_im0 + nrm(ks[8], (DEPTH, G, N), 0.01),
        's5_log_dt': log_dt,
        's5_b_re': nrm(ks[9], (DEPTH, G, N, S5_GROUP), (2 * S5_GROUP) ** -0.5),
        's5_b_im': nrm(ks[10], (DEPTH, G, N, S5_GROUP), (2 * S5_GROUP) ** -0.5),
        's5_c_re': nrm(ks[11], (DEPTH, G, S5_GROUP, N), N ** -0.5),
        's5_c_im': nrm(ks[12], (DEPTH, G, S5_GROUP, N), N ** -0.5),
        's5_d': nrm(ks[13], (DEPTH, G, S5_GROUP), 1.0),
        's5_w_glu': nrm(ks[14], (DEPTH, D_S5, D_S5), D_S5 ** -0.5),
        's5_b_glu': nrm(ks[15], (DEPTH, D_S5), 0.02),
        's5_norm_g': 1.0 + nrm(ks[16], (DEPTH, D_S5), 0.02),
        'gla_w_g2': nrm(ks[17], (DEPTH, GLA_LOWRANK, GLA_QK), GLA_LOWRANK ** -0.5),
        'gla_b_g2': nrm(ks[18], (DEPTH, GLA_QK), 0.02),
        'gla_norm_g': 1.0 + nrm(ks[19], (DEPTH, GLA_DV), 0.02),
        'w_out': nrm(ks[20], (DEPTH, D_MIX, D), D_MIX ** -0.5),
        'g_norm_moe': 1.0 + nrm(ks[21], (DEPTH, D), 0.02),
        'w_router': nrm(ks[22], (DEPTH, D, N_EXPERTS), D ** -0.5),
        'router_bias': nrm(ks[23], (DEPTH, N_EXPERTS), 0.01),
        'exp_w_gate': nrm(ks[24], (DEPTH, N_EXPERTS, D, D_EXPERT), D ** -0.5),
        'exp_w_up': nrm(ks[25], (DEPTH, N_EXPERTS, D, D_EXPERT), D ** -0.5),
        'exp_w_down': nrm(ks[26], (DEPTH, N_EXPERTS, D_EXPERT, D), D_EXPERT ** -0.5),
        'sh_w_gate': nrm(ks[27], (DEPTH, D, D_EXPERT), D ** -0.5),
        'sh_w_up': nrm(ks[28], (DEPTH, D, D_EXPERT), D ** -0.5),
        'sh_w_down': nrm(ks[29], (DEPTH, D_EXPERT, D), D_EXPERT ** -0.5),
        'g_final': 1.0 + nrm(ks[30], (D,), 0.02),
    }


def reference(x, c, w_ada, b_ada, g_norm_mix, w_in, s5_lambda_re, s5_lambda_im, s5_log_dt,
              s5_b_re, s5_b_im, s5_c_re, s5_c_im, s5_d, s5_w_glu, s5_b_glu, s5_norm_g,
              gla_w_g2, gla_b_g2, gla_norm_g, w_out, g_norm_moe, w_router, router_bias,
              exp_w_gate, exp_w_up, exp_w_down, sh_w_gate, sh_w_up, sh_w_down, g_final):
    splits = [D_S5, D_S5 + GLA_QK, D_S5 + 2 * GLA_QK, D_S5 + 2 * GLA_QK + D_GLA,
              D_S5 + 2 * GLA_QK + D_GLA + GLA_LOWRANK]
    for l in range(DEPTH):
        mod = jax.nn.silu(c) @ w_ada[l] + b_ada[l]
        sh1, sc1, gt1, sh2, sc2, gt2 = jnp.split(mod, 6, axis=-1)
        h = modulate(rmsnorm(x, g_norm_mix[l]), sh1, sc1)
        proj = h @ w_in[l]
        u, q, k, v, glr, r = jnp.split(proj, splits, axis=-1)
        y_s5 = s5_mixer(u, s5_lambda_re[l], s5_lambda_im[l], s5_log_dt[l], s5_b_re[l], s5_b_im[l],
                        s5_c_re[l], s5_c_im[l], s5_d[l], s5_w_glu[l], s5_b_glu[l], s5_norm_g[l])
        y_gla = gla_mixer(q, k, v, glr, r, gla_w_g2[l], gla_b_g2[l], gla_norm_g[l])
        mix = jnp.concatenate([y_s5, y_gla], axis=-1) @ w_out[l]
        x = x + gt1[:, None, :] * mix
        h2 = modulate(rmsnorm(x, g_norm_moe[l]), sh2, sc2)
        y_moe = moe(h2, w_router[l], router_bias[l], exp_w_gate[l], exp_w_up[l], exp_w_down[l],
                    sh_w_gate[l], sh_w_up[l], sh_w_down[l])
        x = x + gt2[:, None, :] * y_moe
    return rmsnorm(x, g_final)
```

```cpp
#include <hip/hip_runtime.h>
#include <cstdio>
#include <cstdint>
#include <cmath>

typedef unsigned short bf16_t;

constexpr int BATCH = 16, SEQ = 2048, DM = 1024, T = BATCH * SEQ;
constexpr int D_S5 = 512, S5_G = 32, S5_C = 16, S5_N = 64;
constexpr int GLA_H = 4, GLA_DK = 64, GLA_DV = 128, GLA_QK = 256, D_GLA = 512;
constexpr int D_IN = 2064;
constexpr int NE = 256, TOPK = 8, DE = 256;
constexpr int NPAIR = T * TOPK;
constexpr float EPS = 1e-6f, ROUTED_SCALE = 2.5f;
constexpr int NT = 512;

constexpr size_t MiB = (size_t)1 << 20;
constexpr size_t WS_CTL = 0;
constexpr size_t CTL_COUNTS = 32768;
constexpr int CNT_STRIDE = 32;
constexpr size_t CTL_BAR = 16384;
constexpr size_t WS_MOD = 1 * MiB;
constexpr size_t WS_WCOMB = 2 * MiB;
constexpr size_t WS_S5P = 3 * MiB;
constexpr size_t WS_PAIRI = 4 * MiB;
constexpr size_t WS_PAIRG = 5 * MiB;
constexpr size_t WS_LIST = 6 * MiB;
constexpr size_t LIST_ENTRIES = (size_t)NPAIR + 256 * 256;
constexpr size_t WS_SEG = 7 * MiB + 512 * 1024;
constexpr size_t WS_WINT = 8 * MiB, WS_WGLUT = 13 * MiB, WS_WOUTT = 14 * MiB, WS_WRS = 16 * MiB, WS_WSDT = 18 * MiB;
constexpr size_t WS_RSS1 = 19 * MiB, WS_RSS2 = 20 * MiB;
constexpr size_t WS_WGU = 24 * MiB, WS_WD = 152 * MiB, WS_H2 = 216 * MiB, WS_YSH = 280 * MiB, WS_Y = 344 * MiB, WS_H = 856 * MiB  , WS_HSH = 1006 * MiB;
constexpr size_t WS_HBUF = 344 * MiB, WS_PROJ = 408 * MiB, WS_LOGA = 536 * MiB, WS_GBUF = 568 * MiB, WS_MIX = 600 * MiB, WS_LOGITS = 664 * MiB;
constexpr size_t WS_WD1 = 760 * MiB;
constexpr size_t WS_WGU1B = 824 * MiB;
constexpr size_t WS_WGU1A = 600 * MiB;
constexpr int GU1B_FIRST = 96;
constexpr size_t WS_X1B = 696 * MiB;
constexpr size_t WS_END = 1024 * MiB;

struct P {
    const float* in[31];
    float* out;
    unsigned char* ws;
};
typedef const __attribute__((address_space(4))) P CP;
enum { I_X = 0, I_C, I_WADA, I_BADA, I_GMIX, I_WIN, I_LRE, I_LIM, I_LOGDT, I_BRE, I_BIM, I_CRE, I_CIM, I_S5D, I_WGLU, I_BGLU, I_S5NG,
       I_WG2, I_BG2, I_GLANG, I_WOUT, I_GMOE, I_WR, I_RB, I_EWG, I_EWU, I_EWD, I_SWG, I_SWU, I_SWD, I_GFIN };

__device__ __forceinline__ bf16_t f2bf(float f) { __bf16 b = (__bf16)f; return __builtin_bit_cast(unsigned short, b); }
__device__ __forceinline__ float bf2f(bf16_t h) { return __uint_as_float(((unsigned)h) << 16); }
__device__ __forceinline__ float sigmoidf_(float x) { return 1.f / (1.f + expf(-x)); }
__device__ __forceinline__ float siluf_(float x) { return x * sigmoidf_(x); }
__device__ __forceinline__ float gelu_tanh(float x) { const float k = 0.7978845608028654f; return 0.5f * x * (1.f + tanhf(k * (x + 0.044715f * x * x * x))); }
__device__ __forceinline__ float wave_sum(float v) {
#pragma unroll
    for (int o = 1; o < 64; o <<= 1) v += __shfl_xor(v, o);
    return v;
}

namespace g8 {
#define G8_LAS __attribute__((address_space(3)))
typedef short bf16x8 __attribute__((ext_vector_type(8)));
typedef float f32x4 __attribute__((ext_vector_type(4)));
typedef unsigned u32x4 __attribute__((ext_vector_type(4)));
typedef unsigned u32x2 __attribute__((ext_vector_type(2)));
constexpr int BM = 256, BK = 64, HALF = 128, HTB = HALF * BK * 2, STAGE_BYTES = 8 * HTB, NXCD = 8, WGM = 8;

__host__ __device__ __forceinline__ int lds_byte(int r, int c) { const int st = (r >> 4) * 2 + (c >> 5), rr = r & 15, cc = c & 31, ob = rr * 64 + cc * 2; return st * 1024 + (ob ^ (((ob >> 9) & 1) << 5)); }
__host__ __device__ __forceinline__ void stage_rc(int b, int& R, int& C) { const int st = b / 1024, sb = b % 1024, swz = sb ^ (((sb >> 9) & 1) << 5); R = (st >> 1) * 16 + swz / 64; C = (st & 1) * 32 + (swz % 64) / 2; }
__host__ __device__ __forceinline__ int perm32(int rho) { const int n = rho >> 4, i = rho & 15; return 8 * (i >> 2) + 4 * n + (i & 3); }

struct Unit { int pm, pn, e, cnt, seg; };

__device__ __forceinline__ unsigned cvt_pk_bf16(float lo, float hi) { unsigned r; asm volatile("v_cvt_pk_bf16_f32 %0, %1, %2" : "=v"(r) : "v"(lo), "v"(hi)); return r; }

struct DenseOrder {
    const char* A; const char* Bt; int K; int nM, nN, nwg, G, c;
    __device__ void init(const void* A_, const void* Bt_, int M, int N, int K_, int G_, int c_) { A = (const char*)A_; Bt = (const char*)Bt_; K = K_; nM = M / BM; nN = N / BM; nwg = nM * nN; G = G_; c = c_; }
    __device__ bool next(int i, Unit& u) const {
        const long L = (long)i * G + c; if (L >= nwg) return false;
        int wgid = (int)L; { const int q = nwg / NXCD, r = nwg % NXCD, xcd = wgid % NXCD, off = wgid / NXCD; wgid = (xcd < r ? xcd * (q + 1) : r * (q + 1) + (xcd - r) * q) + off; }
        const int nig = WGM * nN, gid = wgid / nig, fm = gid * WGM, gsz = (nM - fm) < WGM ? (nM - fm) : WGM;
        u.pm = fm + ((wgid % nig) % gsz); u.pn = (wgid % nig) / gsz; u.e = 0; u.cnt = BM; u.seg = 0; return true;
    }
    __device__ __forceinline__ const char* a_ptr(const Unit& u) const { return A + (size_t)u.pm * BM * K * 2; }
    __device__ __forceinline__ const char* b_ptr(const Unit& u) const { return Bt + (size_t)u.pn * BM * K * 2; }
    __device__ __forceinline__ const int* rows(const Unit&) const { return nullptr; }
};

template <class Epi, class Sched, bool GATHER, bool ALIGN_EPI, bool TILEDB = false>
__device__ __forceinline__ void gemm_phase(G8_LAS unsigned char* lds, G8_LAS unsigned* gslot, const int K, const Sched& S, Epi& E) {
    int tid_ = threadIdx.x; asm volatile("" : "+v"(tid_));
    const int tid = tid_, wid = __builtin_amdgcn_readfirstlane(tid >> 6), lane = tid & 63, wr = wid >> 2, wc = wid & 3, fr = lane & 15, fq = lane >> 4;
    const int nt = K / BK;
    unsigned voffA[2], voffB[2]; int R0 = 0, C0 = 0;
#pragma unroll
    for (int i = 0; i < 2; ++i) { int R, C; stage_rc(tid * 16 + i * 8192, R, C); const int Rb = Epi::PERM ? ((R & ~31) + perm32(R & 31)) : R;
        voffA[i] = (unsigned)(R * K + C) * 2u; voffB[i] = TILEDB ? (unsigned)(Rb * BK + C) * 2u : (unsigned)(Rb * K + C) * 2u; if (i == 0) { R0 = R; C0 = C; } }
    unsigned aoff[4] = {0u, 0u, 0u, 0u};
    const size_t kstep = (size_t)(BK * 2);
    const size_t hstep = (size_t)HALF * K * 2;
    const size_t kstepB = TILEDB ? (size_t)(BM * BK * 2) : kstep, hstepB = TILEDB ? (size_t)(HALF * BK * 2) : hstep;
    const unsigned ldsw = (unsigned)wid * 1024u;
    const int aoffl = lds_byte(wr * 64 + fr, fq * 8), boffl = lds_byte(wc * 32 + fr, fq * 8);
#define G8_SA(b, h) (((b) * 2 + (h)) * HTB)
#define G8_SB(b, h) ((4 + (b) * 2 + (h)) * HTB)
#define G8_GLDS(gp, lp) __builtin_amdgcn_global_load_lds((const unsigned*)(gp), (G8_LAS unsigned*)(lp), 16, 0, 0)
#define G8_STAGE_B(bufoff, gbase) do { _Pragma("unroll") for (int _i = 0; _i < 2; ++_i) G8_GLDS((const char*)(gbase) + voffB[_i], lds + (bufoff) + ldsw + _i * 8192); } while (0)
#define G8_STAGE_A(bufoff, gbase, h) do { _Pragma("unroll") for (int _i = 0; _i < 2; ++_i) { \
        if constexpr (GATHER) G8_GLDS((const char*)(gbase) + aoff[(h) * 2 + _i], lds + (bufoff) + ldsw + _i * 8192); \
        else G8_GLDS((const char*)(gbase) + (h) * hstep + voffA[_i], lds + (bufoff) + ldsw + _i * 8192); } } while (0)
#define G8_LDA(dst, b, h) do { _Pragma("unroll") for (int m = 0; m < 4; ++m) _Pragma("unroll") for (int k = 0; k < 2; ++k) dst[m][k] = *(const G8_LAS bf16x8*)(lds + G8_SA(b, h) + aoffl + m * 2048 + k * 1024); } while (0)
#define G8_LDB(dst, b, h) do { _Pragma("unroll") for (int n = 0; n < 2; ++n) _Pragma("unroll") for (int k = 0; k < 2; ++k) dst[n][k] = *(const G8_LAS bf16x8*)(lds + G8_SB(b, h) + boffl + n * 2048 + k * 1024); } while (0)
#define G8_MMA(ai, bj, At, Bt) do { __builtin_amdgcn_s_setprio(1); _Pragma("unroll") for (int m = 0; m < 4; ++m) _Pragma("unroll") for (int n = 0; n < 2; ++n) _Pragma("unroll") for (int k = 0; k < 2; ++k) \
        acc[ai][bj][m][n] = __builtin_amdgcn_mfma_f32_16x16x32_bf16(Bt[n][k], At[m][k], acc[ai][bj][m][n], 0, 0, 0); __builtin_amdgcn_s_setprio(0); } while (0)
#define G8_WAIT_V(n) asm volatile("s_waitcnt vmcnt(" #n ")" ::: "memory")
#define G8_WAIT_L(n) asm volatile("s_waitcnt lgkmcnt(" #n ")" ::: "memory")
#define G8_BAR __builtin_amdgcn_s_barrier()
#define G8_SCHED __builtin_amdgcn_sched_barrier(0)
#define G8_LOAD_AOFF(rowsp, dstarr) do { _Pragma("unroll") for (int _j = 0; _j < 4; ++_j) { const int _q = (rowsp)[(_j >> 1) * 128 + (_j & 1) * 64 + R0]; const unsigned _tok = _q < 0 ? 0u : (unsigned)(_q >> 3); dstarr[_j] = _tok * (unsigned)(K * 2) + (unsigned)(C0 * 2); } } while (0)
    Unit cur, nxt; int ui = 0;
    if (!S.next(0, cur)) return;
    f32x4 acc[2][2][4][2];
#pragma unroll
    for (int a = 0; a < 2; ++a)
#pragma unroll
        for (int b = 0; b < 2; ++b)
#pragma unroll
            for (int m = 0; m < 4; ++m)
#pragma unroll
                for (int n = 0; n < 2; ++n) acc[a][b][m][n] = (f32x4){0.f, 0.f, 0.f, 0.f};
    bf16x8 At[4][2], B0[2][2], B1[2][2];
    const char* cA = S.a_ptr(cur); const char* cB = S.b_ptr(cur);
    if constexpr (GATHER) { const int* rp = S.rows(cur); G8_LOAD_AOFF(rp, aoff); }
    G8_STAGE_B(G8_SB(0, 0), cB); G8_STAGE_B(G8_SB(0, 1), cB + hstepB); G8_STAGE_A(G8_SA(0, 0), cA, 0); G8_STAGE_A(G8_SA(0, 1), cA, 1);
    if (wr == 1) G8_BAR;
    G8_WAIT_V(2); G8_BAR;
    G8_STAGE_B(G8_SB(1, 0), cB + kstepB); G8_STAGE_A(G8_SA(1, 0), cA + kstep, 0); G8_STAGE_B(G8_SB(1, 1), cB + hstepB + kstepB);
    G8_WAIT_V(6); G8_BAR;
    for (;;) {
        const bool has_next = S.next(ui + 1, nxt);
        const char* nA = has_next ? S.a_ptr(nxt) : cA; const char* nB = has_next ? S.b_ptr(nxt) : cB;
        if constexpr (GATHER) { if (has_next) { const int* rp = S.rows(nxt); unsigned na[4]; G8_LOAD_AOFF(rp, na);
#pragma unroll
                for (int j = 0; j < 4; ++j) gslot[tid * 4 + j] = na[j]; } }
        if constexpr (Epi::PREFETCH) E.pre(cur, wr, fr);
#pragma nounroll
        for (int t = 0; t < nt; t += 2) {
            const bool last = (t == nt - 2);
            const char* a1 = cA + (size_t)(t + 1) * kstep;
            const char* a2 = last ? nA : cA + (size_t)(t + 2) * kstep; const char* b2 = last ? nB : cB + (size_t)(t + 2) * kstepB;
            const char* a3 = a2 + kstep; const char* b3 = b2 + kstepB;
            if constexpr (Epi::MIDK > 0) { if (t == Epi::MIDK) E.mid(acc, cur, wr, wc, fr, fq); }
            G8_LDB(B0, 0, 0); G8_LDB(B1, 0, 1); G8_SCHED; G8_LDA(At, 0, 0); G8_STAGE_A(G8_SA(1, 1), a1, 1);
            if constexpr (GATHER) { if (last && has_next) {
#pragma unroll
                for (int j = 0; j < 4; ++j) aoff[j] = gslot[tid * 4 + j]; } }
            G8_WAIT_V(8); G8_WAIT_L(0); G8_BAR; G8_MMA(0, 0, At, B0); G8_MMA(0, 1, At, B1); G8_BAR; G8_SCHED;
            G8_LDA(At, 0, 1); G8_STAGE_B(G8_SB(0, 0), b2); G8_STAGE_B(G8_SB(0, 1), b2 + hstepB); G8_STAGE_A(G8_SA(0, 0), a2, 0);
            G8_WAIT_V(8); G8_WAIT_L(0); G8_BAR; G8_MMA(1, 0, At, B0); G8_MMA(1, 1, At, B1); G8_BAR; G8_SCHED;
            G8_LDB(B0, 1, 0); G8_LDB(B1, 1, 1); G8_SCHED; G8_LDA(At, 1, 0); G8_STAGE_A(G8_SA(0, 1), a2, 1);
            G8_WAIT_V(8); G8_WAIT_L(0); G8_BAR; G8_MMA(0, 0, At, B0); G8_MMA(0, 1, At, B1); G8_BAR; G8_SCHED;
            G8_LDA(At, 1, 1); G8_STAGE_B(G8_SB(1, 0), b3); G8_STAGE_B(G8_SB(1, 1), b3 + hstepB); G8_STAGE_A(G8_SA(1, 0), a3, 0);
            G8_WAIT_V(8); G8_WAIT_L(0); G8_BAR; G8_MMA(1, 0, At, B0); G8_MMA(1, 1, At, B1); G8_BAR; G8_SCHED;
        }
        if (ALIGN_EPI) { if (wr == 0) G8_BAR; }
        E(acc, cur, wr, wc, fr, fq);
        if (!has_next) break;
#pragma unroll
        for (int a = 0; a < 2; ++a)
#pragma unroll
            for (int b = 0; b < 2; ++b)
#pragma unroll
                for (int m = 0; m < 4; ++m)
#pragma unroll
                    for (int n = 0; n < 2; ++n) acc[a][b][m][n] = (f32x4){0.f, 0.f, 0.f, 0.f};
        cur = nxt; cA = nA; cB = nB; ++ui;
        if (ALIGN_EPI) { if (wr == 1) G8_BAR; }
    }
    G8_WAIT_V(0);
    if (!ALIGN_EPI) { if (wr == 0) G8_BAR; }
    G8_BAR;
#undef G8_SA
#undef G8_SB
#undef G8_GLDS
#undef G8_STAGE_A
#undef G8_STAGE_B
#undef G8_LDA
#undef G8_LDB
#undef G8_MMA
#undef G8_WAIT_V
#undef G8_WAIT_L
#undef G8_BAR
#undef G8_SCHED
#undef G8_LOAD_AOFF
}
}
namespace g8 {
__device__ __forceinline__ float logsig16(float x) { return (fminf(x, 0.f) - log1pf(__expf(-fabsf(x)))) * (1.f / 16.f); }
__device__ __forceinline__ float fsigmoid(float x) { return __builtin_amdgcn_rcpf(1.f + __expf(-x)); }

struct EpiInproj {
    static constexpr bool PERM = true; static constexpr int MIDK = 0; static constexpr bool PREFETCH = false;
    bf16_t* proj; float* loga; const float* bg2;
    __device__ __forceinline__ void operator()(const f32x4 (&acc)[2][2][4][2], const Unit& u, int wr, int wc, int fr, int fq) const {
        const int row0 = u.pm * BM + wr * 64 + fr;
        if (u.pn < 8) {
            const int col0 = u.pn * BM + wc * 32 + 8 * fq;
#pragma unroll
            for (int ai = 0; ai < 2; ++ai)
#pragma unroll
                for (int m = 0; m < 4; ++m) { bf16_t* rowp = proj + (size_t)(row0 + ai * HALF + m * 16) * 2048 + col0;
#pragma unroll
                    for (int bj = 0; bj < 2; ++bj) { const f32x4 v0 = acc[ai][bj][m][0], v1 = acc[ai][bj][m][1]; u32x4 w;
                        w.x = cvt_pk_bf16(v0[0], v0[1]); w.y = cvt_pk_bf16(v0[2], v0[3]); w.z = cvt_pk_bf16(v1[0], v1[1]); w.w = cvt_pk_bf16(v1[2], v1[3]);
                        *(u32x4*)(rowp + bj * HALF) = w; } }
        } else {
            const int col0 = wc * 32 + 8 * fq;
            f32x4 bv[2][2];
#pragma unroll
            for (int bj = 0; bj < 2; ++bj)
#pragma unroll
                for (int n = 0; n < 2; ++n) bv[bj][n] = *(const f32x4*)(bg2 + col0 + bj * HALF + 4 * n);
#pragma unroll
            for (int ai = 0; ai < 2; ++ai)
#pragma unroll
                for (int m = 0; m < 4; ++m) { float* rowp = loga + (size_t)(row0 + ai * HALF + m * 16) * 256 + col0;
#pragma unroll
                    for (int bj = 0; bj < 2; ++bj)
#pragma unroll
                        for (int n = 0; n < 2; ++n) { const f32x4 x = acc[ai][bj][m][n] + bv[bj][n]; f32x4 o;
                            o[0] = logsig16(x[0]); o[1] = logsig16(x[1]); o[2] = logsig16(x[2]); o[3] = logsig16(x[3]);
                            *(f32x4*)(rowp + bj * HALF + 4 * n) = o; } }
        }
    }
};

struct EpiGlu {
    static constexpr bool PERM = true; static constexpr int MIDK = 0; static constexpr bool PREFETCH = false;
    const bf16_t* gb; bf16_t* mix; const float* bgl; float* rowss;
    __device__ __forceinline__ void operator()(const f32x4 (&acc)[2][2][4][2], const Unit& u, int wr, int wc, int fr, int fq) const {
        const int row0 = u.pm * BM + wr * 64 + fr, col0 = u.pn * BM + wc * 32 + 8 * fq;
        f32x4 bv[2][2];
#pragma unroll
        for (int bj = 0; bj < 2; ++bj)
#pragma unroll
            for (int n = 0; n < 2; ++n) bv[bj][n] = *(const f32x4*)(bgl + col0 + bj * HALF + 4 * n);
#pragma unroll
        for (int ai = 0; ai < 2; ++ai)
#pragma unroll
            for (int m = 0; m < 4; ++m) { const int row = row0 + ai * HALF + m * 16; float ss = 0.f;
#pragma unroll
                for (int bj = 0; bj < 2; ++bj) { const u32x4 gw = *(const u32x4*)(gb + (size_t)row * 512 + col0 + bj * HALF);
                    float g[8]; g[0] = __uint_as_float(gw.x << 16); g[1] = __uint_as_float(gw.x & 0xffff0000u); g[2] = __uint_as_float(gw.y << 16); g[3] = __uint_as_float(gw.y & 0xffff0000u);
                    g[4] = __uint_as_float(gw.z << 16); g[5] = __uint_as_float(gw.z & 0xffff0000u); g[6] = __uint_as_float(gw.w << 16); g[7] = __uint_as_float(gw.w & 0xffff0000u);
                    float o[8];
#pragma unroll
                    for (int n = 0; n < 2; ++n)
#pragma unroll
                        for (int j = 0; j < 4; ++j) { const float v = g[n * 4 + j] * fsigmoid(acc[ai][bj][m][n][j] + bv[bj][n][j]); o[n * 4 + j] = v; ss += v * v; }
                    u32x4 w; w.x = cvt_pk_bf16(o[0], o[1]); w.y = cvt_pk_bf16(o[2], o[3]); w.z = cvt_pk_bf16(o[4], o[5]); w.w = cvt_pk_bf16(o[6], o[7]);
                    *(u32x4*)(mix + (size_t)row * DM + col0 + bj * HALF) = w; }
                ss += __shfl_xor(ss, 16); ss += __shfl_xor(ss, 32);
                if (fq == 0) rowss[(size_t)u.pn * (T * 4) + (size_t)row * 4 + wc] = ss; }
    }
};

struct EpiWout {
    static constexpr bool PERM = true; static constexpr int MIDK = 8; static constexpr bool PREFETCH = false;
    const float* x; bf16_t* x1b; const float* mod; const float* rowss1; float* rowss2;
    __device__ __forceinline__ void mid(f32x4 (&acc)[2][2][4][2], const Unit& u, int wr, int wc, int fr, int fq) const {
        const int row0 = u.pm * BM + wr * 64 + fr;
        float sm[2];
#pragma unroll
        for (int i = 0; i < 2; ++i) { const int idx = 2 * fq + i; const float* rp = rowss1 + (size_t)(row0 + (idx >> 2) * HALF + (idx & 3) * 16) * 4;
            const f32x4 q0 = *(const f32x4*)rp, q1 = *(const f32x4*)(rp + (size_t)T * 4);
            float sq = q0[0]; sq += q0[1]; sq += q0[2]; sq += q0[3]; sq += q1[0]; sq += q1[1]; sq += q1[2]; sq += q1[3];
            sm[i] = rsqrtf(sq * (1.f / 512.f) + EPS); asm volatile("" ::: "memory"); }
#pragma unroll
        for (int idx = 0; idx < 8; ++idx) { const float s = __shfl(sm[idx & 1], fr + 16 * (idx >> 1));
#pragma unroll
            for (int bj = 0; bj < 2; ++bj)
#pragma unroll
                for (int n = 0; n < 2; ++n) acc[idx >> 2][bj][idx & 3][n] *= s; }
    }
    __device__ __forceinline__ void operator()(const f32x4 (&acc)[2][2][4][2], const Unit& u, int wr, int wc, int fr, int fq) const {
        const int row0 = u.pm * BM + wr * 64 + fr, col0 = u.pn * BM + wc * 32 + 8 * fq;
        const int b = (u.pm * BM) / SEQ;
        f32x4 gt[2][2];
#pragma unroll
        for (int bj = 0; bj < 2; ++bj)
#pragma unroll
            for (int n = 0; n < 2; ++n) gt[bj][n] = *(const f32x4*)(mod + b * 6 * DM + 2 * DM + col0 + bj * HALF + 4 * n);
#pragma unroll
        for (int ai = 0; ai < 2; ++ai)
#pragma unroll
            for (int m = 0; m < 4; ++m) { const int row = row0 + ai * HALF + m * 16; const size_t off = (size_t)row * DM + col0; float ss = 0.f;
#pragma unroll
                for (int bj = 0; bj < 2; ++bj) { const f32x4 x0 = *(const f32x4*)(x + off + bj * HALF), x1v = *(const f32x4*)(x + off + bj * HALF + 4);
                    const f32x4 o0 = x0 + gt[bj][0] * acc[ai][bj][m][0], o1 = x1v + gt[bj][1] * acc[ai][bj][m][1];
                    u32x4 w; w.x = cvt_pk_bf16(o0[0], o0[1]); w.y = cvt_pk_bf16(o0[2], o0[3]); w.z = cvt_pk_bf16(o1[0], o1[1]); w.w = cvt_pk_bf16(o1[2], o1[3]);
                    *(u32x4*)(x1b + off + bj * HALF) = w;
                    ss += (o0[0] * o0[0] + o0[1] * o0[1]) + (o0[2] * o0[2] + o0[3] * o0[3]) + (o1[0] * o1[0] + o1[1] * o1[1]) + (o1[2] * o1[2] + o1[3] * o1[3]); }
                ss += __shfl_xor(ss, 16); ss += __shfl_xor(ss, 32);
                if (fq == 0) rowss2[(size_t)u.pn * (T * 4) + (size_t)row * 4 + wc] = ss; }
    }
};

struct EpiRS {
    static constexpr bool PERM = true; static constexpr int MIDK = 0; static constexpr bool PREFETCH = false;
    float* logits; bf16_t* Hs;
    __device__ __forceinline__ void operator()(const f32x4 (&acc)[2][2][4][2], const Unit& u, int wr, int wc, int fr, int fq) const {
        const int row0 = u.pm * BM + wr * 64 + fr, c0 = wc * 32 + 8 * fq;
        if (u.pn == 0) {
#pragma unroll
            for (int ai = 0; ai < 2; ++ai)
#pragma unroll
                for (int m = 0; m < 4; ++m) { float* rowp = logits + (size_t)(row0 + ai * HALF + m * 16) * 256 + c0;
#pragma unroll
                    for (int bj = 0; bj < 2; ++bj)
#pragma unroll
                        for (int n = 0; n < 2; ++n) *(f32x4*)(rowp + bj * HALF + 4 * n) = acc[ai][bj][m][n]; }
        } else {
            const int hc = (u.pn - 1) * 128 + c0;
#pragma unroll
            for (int ai = 0; ai < 2; ++ai)
#pragma unroll
                for (int m = 0; m < 4; ++m) { float o[8];
#pragma unroll
                    for (int n = 0; n < 2; ++n)
#pragma unroll
                        for (int j = 0; j < 4; ++j) { const float g = acc[ai][0][m][n][j], up = acc[ai][1][m][n][j]; o[n * 4 + j] = g * fsigmoid(g) * up; }
                    u32x4 w; w.x = cvt_pk_bf16(o[0], o[1]); w.y = cvt_pk_bf16(o[2], o[3]); w.z = cvt_pk_bf16(o[4], o[5]); w.w = cvt_pk_bf16(o[6], o[7]);
                    *(u32x4*)(Hs + (size_t)(row0 + ai * HALF + m * 16) * DE + hc) = w; }
        }
    }
};

struct EpiPlain {
    static constexpr bool PERM = true; static constexpr int MIDK = 0; static constexpr bool PREFETCH = false;
    bf16_t* O; int ldc;
    __device__ __forceinline__ void operator()(const f32x4 (&acc)[2][2][4][2], const Unit& u, int wr, int wc, int fr, int fq) const {
        const int row0 = u.pm * BM + wr * 64 + fr, col0 = u.pn * BM + wc * 32 + 8 * fq;
#pragma unroll
        for (int ai = 0; ai < 2; ++ai)
#pragma unroll
            for (int m = 0; m < 4; ++m) { bf16_t* rowp = O + (size_t)(row0 + ai * HALF + m * 16) * ldc + col0;
#pragma unroll
                for (int bj = 0; bj < 2; ++bj) { const f32x4 v0 = acc[ai][bj][m][0], v1 = acc[ai][bj][m][1]; u32x4 w;
                    w.x = cvt_pk_bf16(v0[0], v0[1]); w.y = cvt_pk_bf16(v0[2], v0[3]); w.z = cvt_pk_bf16(v1[0], v1[1]); w.w = cvt_pk_bf16(v1[2], v1[3]);
                    *(u32x4*)(rowp + bj * HALF) = w; } }
    }
};
struct EpiFp8 {
    static constexpr bool PERM = true; static constexpr int MIDK = 0; static constexpr bool PREFETCH = false;
    unsigned char* O; int ldc;
    __device__ __forceinline__ void operator()(const f32x4 (&acc)[2][2][4][2], const Unit& u, int wr, int wc, int fr, int fq) const {
        const int row0 = u.pm * BM + wr * 64 + fr, col0 = u.pn * BM + wc * 32 + ((fq & 1) ? HALF + 8 * (fq - 1) : 8 * fq);
#pragma unroll
        for (int ai = 0; ai < 2; ++ai)
#pragma unroll
            for (int m = 0; m < 4; ++m) { u32x2 w0, w1; w0.x = w0.y = w1.x = w1.y = 0u;
#if defined(__HIP_DEVICE_COMPILE__)
                { const f32x4 v0 = acc[ai][0][m][0] * 16.f, v1 = acc[ai][0][m][1] * 16.f;
                  w0.x = __builtin_amdgcn_cvt_pk_fp8_f32(v0[0], v0[1], w0.x, false); w0.x = __builtin_amdgcn_cvt_pk_fp8_f32(v0[2], v0[3], w0.x, true);
                  w0.y = __builtin_amdgcn_cvt_pk_fp8_f32(v1[0], v1[1], w0.y, false); w0.y = __builtin_amdgcn_cvt_pk_fp8_f32(v1[2], v1[3], w0.y, true); }
                { const f32x4 v0 = acc[ai][1][m][0] * 16.f, v1 = acc[ai][1][m][1] * 16.f;
                  w1.x = __builtin_amdgcn_cvt_pk_fp8_f32(v0[0], v0[1], w1.x, false); w1.x = __builtin_amdgcn_cvt_pk_fp8_f32(v0[2], v0[3], w1.x, true);
                  w1.y = __builtin_amdgcn_cvt_pk_fp8_f32(v1[0], v1[1], w1.y, false); w1.y = __builtin_amdgcn_cvt_pk_fp8_f32(v1[2], v1[3], w1.y, true); }
                { const bool od = fq & 1;
                  const unsigned rx = (unsigned)__shfl_xor((int)(od ? w0.x : w1.x), 16), ry = (unsigned)__shfl_xor((int)(od ? w0.y : w1.y), 16);
                  w0.x = od ? rx : w0.x; w1.x = od ? w1.x : rx; w0.y = od ? ry : w0.y; w1.y = od ? w1.y : ry; }
#endif
                u32x4 o; o.x = w0.x; o.y = w0.y; o.z = w1.x; o.w = w1.y; *(u32x4*)(O + (size_t)(row0 + ai * HALF + m * 16) * ldc + col0) = o; }
    }
};
}
constexpr int LDS_RING = 131072, LDS_GSLOT = 131072, LDS_TOTAL = 147456;
struct TrItem { const float* src; int ld; bf16_t* dst; int Kd; int gs; const float* ksc; };
__device__ __forceinline__ void tr_load(const TrItem& it, float4 (&v)[8]) {
    const int tid = threadIdx.x, n4 = tid & 63, kq = tid >> 6;
#pragma unroll
    for (int i = 0; i < 8; ++i) { typedef float f32x4v __attribute__((ext_vector_type(4))); const f32x4v t = *(const f32x4v*)(it.src + (size_t)(i * 8 + kq) * it.ld + n4 * 4); v[i] = make_float4(t[0], t[1], t[2], t[3]); }
}
__device__ __forceinline__ void tr_to_lds(const TrItem& it, const float4 (&v)[8], float* lds) {
    const int tid = threadIdx.x, n4 = tid & 63, kq = tid >> 6;
#pragma unroll
    for (int i = 0; i < 8; ++i) { const int k = i * 8 + kq; const float s = it.ksc ? it.ksc[k] : 1.f; const int col = (n4 * 4 + 4 * (k >> 3)) & 255;
        float4 w = v[i]; w.x *= s; w.y *= s; w.z *= s; w.w *= s; *(float4*)(lds + k * 260 + col) = w; }
}
__device__ __forceinline__ void tr_store(const TrItem& it, const float* lds) {
    const int tid = threadIdx.x;
#pragma unroll
    for (int i = 0; i < 4; ++i) { const int c = tid + i * NT, n = c >> 3, k8 = c & 7, col = (n + 4 * k8) & 255;
        float f[8];
#pragma unroll
        for (int j = 0; j < 8; ++j) f[j] = lds[(k8 * 8 + j) * 260 + col];
        uint4 o; o.x = (unsigned)f2bf(f[0]) | ((unsigned)f2bf(f[1]) << 16); o.y = (unsigned)f2bf(f[2]) | ((unsigned)f2bf(f[3]) << 16);
        o.z = (unsigned)f2bf(f[4]) | ((unsigned)f2bf(f[5]) << 16); o.w = (unsigned)f2bf(f[6]) | ((unsigned)f2bf(f[7]) << 16);
        const int row = (n >> 7) * it.gs + (n & 127);
        *(uint4*)(it.dst + (size_t)row * it.Kd + k8 * 8) = o; }
}
template <class Get>
__device__ __forceinline__ void tr_run(int first, int step, int count, Get get, float* lds) {
    if (first >= count) return;
    const int nmine = (count - first + step - 1) / step;
    auto at = [&](int j) { return get(first + (j < nmine ? j : nmine - 1) * step); };
    TrItem A = at(0), B = at(1); float4 vA[8], vB[8];
    tr_load(A, vA); tr_load(B, vB);
#pragma nounroll
    for (int j = 0; j < nmine; j += 2) {
        tr_to_lds(A, vA, lds);
        __syncthreads();
        const TrItem A2 = at(j + 2); tr_load(A2, vA);
        tr_store(A, lds);
        __syncthreads();
        tr_to_lds(B, vB, lds);
        __syncthreads();
        const TrItem B2 = at(j + 3); tr_load(B2, vB);
        tr_store(B, lds);
        __syncthreads();
        A = A2; B = B2;
    }
}
__device__ __forceinline__ void conv_small(CP& p, int bid, int nblk, float* lds) {
    bf16_t* WINT = (bf16_t*)(p.ws + WS_WINT); bf16_t* WGLUT = (bf16_t*)(p.ws + WS_WGLUT); bf16_t* WOUTT = (bf16_t*)(p.ws + WS_WOUTT);
    bf16_t* WRS = (bf16_t*)(p.ws + WS_WRS); bf16_t* WSDT = (bf16_t*)(p.ws + WS_WSDT);
    const float* win = p.in[I_WIN]; const float* wglu = p.in[I_WGLU]; const float* wout = p.in[I_WOUT]; const float* wr = p.in[I_WR];
    const float* swg = p.in[I_SWG]; const float* swu = p.in[I_SWU]; const float* swd = p.in[I_SWD]; const float* s5ng = p.in[I_S5NG];
    auto get = [&](int it) -> TrItem {
        int r = it;
        if (r < 96) { const int kb = r / 6, nb = r % 6; return TrItem{win + (size_t)kb * 64 * D_IN + nb * 256, D_IN, WINT + (size_t)nb * 256 * DM + kb * 64, DM, 128, nullptr}; } r -= 96;
        if (r < 32) { const int kb = r / 2, nb = r % 2; return TrItem{win + (size_t)kb * 64 * D_IN + 1552 + nb * 256, D_IN, WINT + (size_t)(1536 + nb * 256) * DM + kb * 64, DM, 128, nullptr}; } r -= 32;
        if (r < 16) { const int kb = r / 2, nb = r % 2; return TrItem{wglu + (size_t)kb * 64 * 512 + nb * 256, 512, WGLUT + (size_t)nb * 256 * 512 + kb * 64, 512, 128, nullptr}; } r -= 16;
        if (r < 64) { const int kb = r / 4, nb = r % 4; return TrItem{wout + (size_t)kb * 64 * DM + nb * 256, DM, WOUTT + (size_t)nb * 256 * DM + kb * 64, DM, 128, kb < 8 ? s5ng + kb * 64 : nullptr}; } r -= 64;
        if (r < 16) { return TrItem{wr + (size_t)r * 64 * 256, 256, WRS + r * 64, DM, 128, nullptr}; } r -= 16;
        if (r < 16) { return TrItem{swg + (size_t)r * 64 * 256, 256, WRS + (size_t)256 * DM + r * 64, DM, 256, nullptr}; } r -= 16;
        if (r < 16) { return TrItem{swu + (size_t)r * 64 * 256, 256, WRS + (size_t)384 * DM + r * 64, DM, 256, nullptr}; } r -= 16;
        { const int kb = r / 4, nb = r % 4; return TrItem{swd + (size_t)kb * 64 * DM + nb * 256, DM, WSDT + (size_t)nb * 256 * DE + kb * 64, DE, 128, nullptr}; }
    };
    tr_run(bid, nblk, 272, get, lds);
    const float* wg2 = p.in[I_WG2];
    for (int i = bid * NT + threadIdx.x; i < 256 * DM; i += nblk * NT) {
        const int n = i >> 10, k = i & 1023; float s = 0.f;
#pragma unroll
        for (int j = 0; j < 16; ++j) s += win[(size_t)k * D_IN + 1536 + j] * wg2[j * GLA_QK + n];
        WINT[(size_t)(2048 + n) * DM + k] = f2bf(s);
    }
}
__device__ __forceinline__ void ph_inproj(CP& p, G8_LAS unsigned char* lds) {
    g8::DenseOrder S; S.init(p.ws + WS_HBUF, p.ws + WS_WINT, T, 2304, DM, gridDim.x, blockIdx.x);
    g8::EpiInproj E{(bf16_t*)(p.ws + WS_PROJ), (float*)(p.ws + WS_LOGA), p.in[I_BG2]};
    g8::gemm_phase<g8::EpiInproj, g8::DenseOrder, false, true>(lds, (G8_LAS unsigned*)(lds + LDS_GSLOT), DM, S, E);
}
__device__ __forceinline__ void ph_glu(CP& p, G8_LAS unsigned char* lds) {
    g8::DenseOrder S; S.init(p.ws + WS_GBUF, p.ws + WS_WGLUT, T, 512, 512, gridDim.x, blockIdx.x);
    g8::EpiGlu E{(const bf16_t*)(p.ws + WS_GBUF), (bf16_t*)(p.ws + WS_MIX), p.in[I_BGLU], (float*)(p.ws + WS_RSS1)};
    g8::gemm_phase<g8::EpiGlu, g8::DenseOrder, false, true>(lds, (G8_LAS unsigned*)(lds + LDS_GSLOT), 512, S, E);
}
__device__ __forceinline__ void ph_wout(CP& p, G8_LAS unsigned char* lds) {
    g8::DenseOrder S; S.init(p.ws + WS_MIX, p.ws + WS_WOUTT, T, DM, DM, gridDim.x, blockIdx.x);
    g8::EpiWout E{p.in[I_X], (bf16_t*)(p.ws + WS_X1B), (const float*)(p.ws + WS_MOD), (const float*)(p.ws + WS_RSS1), (float*)(p.ws + WS_RSS2)};
    g8::gemm_phase<g8::EpiWout, g8::DenseOrder, false, true>(lds, (G8_LAS unsigned*)(lds + LDS_GSLOT), DM, S, E);
}
__device__ __forceinline__ void ph_rs(CP& p, G8_LAS unsigned char* lds, int G) {
    g8::DenseOrder S; S.init(p.ws + WS_H2, p.ws + WS_WRS, T, 768, DM, G, blockIdx.x);
    g8::EpiRS E{(float*)(p.ws + WS_LOGITS), (bf16_t*)(p.ws + WS_HSH)};
    g8::gemm_phase<g8::EpiRS, g8::DenseOrder, false, true>(lds, (G8_LAS unsigned*)(lds + LDS_GSLOT), DM, S, E);
}
__device__ __forceinline__ void ph_sh2(CP& p, G8_LAS unsigned char* lds) {
    g8::DenseOrder S; S.init(p.ws + WS_HSH, p.ws + WS_WSDT, T, DM, DE, gridDim.x, blockIdx.x);
    g8::EpiFp8 E{(unsigned char*)(p.ws + WS_YSH), DM};
    g8::gemm_phase<g8::EpiFp8, g8::DenseOrder, false, true>(lds, (G8_LAS unsigned*)(lds + LDS_GSLOT), DE, S, E);
}
constexpr int LDS_TP = LDS_GSLOT + 8192;
__device__ __forceinline__ void conv_experts(CP& p, int e0, int ne, bool doGU, bool doD, int bid, int nblk, float* lds, int ilo = 0, int ihi = 1 << 30, bool wd1 = false, bool gu1b = false, bool gu1a = false) {
    bf16_t* WGU = (bf16_t*)(p.ws + (gu1b ? WS_WGU1B : (gu1a ? WS_WGU1A : WS_WGU))); bf16_t* WD = (bf16_t*)(p.ws + (wd1 ? WS_WD1 : WS_WD));
    const float* ewg = p.in[I_EWG]; const float* ewu = p.in[I_EWU]; const float* ewd = p.in[I_EWD];
    const int per = (doGU ? 32 : 0) + (doD ? 16 : 0);
    auto get = [&](int it) -> TrItem {
        const int s = it / per; int r = it % per; const int e = e0 + s;
        if (doGU) {
            if (r < 16) return TrItem{ewg + (size_t)e * DM * DE + (size_t)r * 64 * DE, DE, WGU + ((size_t)(s * 2) * 16 + r) * 256 * 64, 64, 4096, nullptr}; r -= 16;
            if (r < 16) return TrItem{ewu + (size_t)e * DM * DE + (size_t)r * 64 * DE, DE, WGU + ((size_t)(s * 2) * 16 + r) * 256 * 64 + 128 * 64, 64, 4096, nullptr}; r -= 16;
        }
        const int kb = r / 4, nb = r % 4;
        return TrItem{ewd + (size_t)e * DE * DM + (size_t)kb * 64 * DM + nb * 256, DM, WD + ((size_t)(s * 4 + nb) * 4 + kb) * 256 * 64, 64, 128, nullptr};
    };
    const int total = ne * per; tr_run(ilo + bid, nblk, ihi < total ? ihi : total, get, lds);
}

namespace g8 {
struct MoeOrder {
    const char* A; const char* Bt; const char* Bt1; const char* Bt2; int es1, es2; const int* list; const int* seg; G8_LAS const int* tp; int K, nN, e0, G, c, nwg; size_t bstride  ; bool a_is_h; bool pn_major = false;
    __device__ void init(const void* A_, const void* Bt_, size_t bstride_, const int* counts, const int* seg_, const int* list_, G8_LAS int* tp_, int K_, int nN_, int e0_, int ne, int G_, int c_, bool a_is_h_) {
        A = (const char*)A_; Bt = (const char*)Bt_; Bt1 = Bt; Bt2 = Bt; es1 = es2 = 1 << 30; bstride = bstride_; list = list_; seg = seg_; K = K_; nN = nN_; e0 = e0_; G = G_; c = c_; a_is_h = a_is_h_;
        if ((int)threadIdx.x < ne) tp_[260 + threadIdx.x] = (counts[(e0_ + threadIdx.x) * CNT_STRIDE] + 255) >> 8;
        __syncthreads();
        if (threadIdx.x == 0) { int s = 0; for (int i = 0; i < ne; ++i) { tp_[i] = s; s += tp_[260 + i]; } tp_[ne] = s; tp_[257] = ne; }
        __syncthreads();
        tp = tp_; nwg = tp_[ne] * nN_;
    }
    __device__ bool next(int i, Unit& u) const {
        const long L = (long)i * G + c; if (L >= nwg) return false;
        int wgid = (int)L; { const int q = nwg / NXCD, r = nwg % NXCD, xcd = wgid % NXCD, off = wgid / NXCD; wgid = (xcd < r ? xcd * (q + 1) : r * (q + 1) + (xcd - r) * q) + off; }
        const int tix = wgid / nN; u.pn = wgid % nN;
        int lo = 0, hi = tp[257];
        while (hi - lo > 1) { const int mid = (lo + hi) >> 1; if (tp[mid] <= tix) lo = mid; else hi = mid; }
        u.e = lo; u.pm = tix - tp[lo]; u.seg = seg[e0 + lo]; u.cnt = 0;
        if (pn_major) { const int nt = tp[lo + 1] - tp[lo], j = wgid - tp[lo] * nN; u.pn = j / nt; u.pm = j % nt; }
        return true;
    }
    __device__ __forceinline__ const char* a_ptr(const Unit& u) const { return a_is_h ? A + ((size_t)(u.seg - seg[e0]) + (size_t)u.pm * BM) * K * 2 : A; }
    __device__ __forceinline__ const char* b_ptr(const Unit& u) const { const char* b = u.e < es1 ? Bt + (size_t)u.e * bstride : (u.e < es2 ? Bt1 + (size_t)(u.e - es1) * bstride : Bt2 + (size_t)(u.e - es2) * bstride); return b + (size_t)u.pn * BM * K * 2; }
    __device__ __forceinline__ const int* rows(const Unit& u) const { return list + u.seg + u.pm * BM; }
};

struct EpiMoe1 {
    static constexpr bool PERM = true; static constexpr int MIDK = 0; static constexpr bool PREFETCH = false;
    bf16_t* H; int seg0;
    __device__ __forceinline__ void operator()(const f32x4 (&acc)[2][2][4][2], const Unit& u, int wr, int wc, int fr, int fq) const {
        const size_t row0 = (size_t)(u.seg - seg0) + u.pm * BM + wr * 64 + fr; const int hc = u.pn * 128 + wc * 32 + 8 * fq;
#pragma unroll
        for (int ai = 0; ai < 2; ++ai)
#pragma unroll
            for (int m = 0; m < 4; ++m) { float o[8];
#pragma unroll
                for (int n = 0; n < 2; ++n)
#pragma unroll
                    for (int j = 0; j < 4; ++j) { const float g = acc[ai][0][m][n][j], up = acc[ai][1][m][n][j]; o[n * 4 + j] = g * fsigmoid(g) * up; }
                u32x4 w; w.x = cvt_pk_bf16(o[0], o[1]); w.y = cvt_pk_bf16(o[2], o[3]); w.z = cvt_pk_bf16(o[4], o[5]); w.w = cvt_pk_bf16(o[6], o[7]);
                *(u32x4*)(H + (row0 + ai * HALF + m * 16) * DE + hc) = w; }
    }
};
struct EpiMoe2 {
    static constexpr bool PERM = true; static constexpr int MIDK = 0; static constexpr bool PREFETCH = false;
    unsigned char* Y; const int* list; const float* pg;
    int qv[8]; float gv[8];
    __device__ __forceinline__ void pre(const Unit& u, int wr, int fr) {
        const int r0 = u.pm * BM + wr * 64 + fr;
#pragma unroll
        for (int i = 0; i < 8; ++i) qv[i] = list[u.seg + r0 + (i >> 2) * HALF + (i & 3) * 16];
#pragma unroll
        for (int i = 0; i < 8; ++i) gv[i] = qv[i] < 0 ? 0.f : pg[qv[i]] * 16.f;
    }
    __device__ __forceinline__ void operator()(const f32x4 (&acc)[2][2][4][2], const Unit& u, int wr, int wc, int fr, int fq) {
        pre(u, wr, fr);
        const int col0 = u.pn * BM + wc * 32 + ((fq & 1) ? HALF + 8 * (fq - 1) : 8 * fq);
#pragma unroll
        for (int ai = 0; ai < 2; ++ai)
#pragma unroll
            for (int m = 0; m < 4; ++m) { const int qq = qv[ai * 4 + m]; const float gt = gv[ai * 4 + m];
                u32x2 w0, w1; w0.x = w0.y = w1.x = w1.y = 0u;
#if defined(__HIP_DEVICE_COMPILE__)
                { const f32x4 v0 = acc[ai][0][m][0] * gt, v1 = acc[ai][0][m][1] * gt;
                  w0.x = __builtin_amdgcn_cvt_pk_fp8_f32(v0[0], v0[1], w0.x, false); w0.x = __builtin_amdgcn_cvt_pk_fp8_f32(v0[2], v0[3], w0.x, true);
                  w0.y = __builtin_amdgcn_cvt_pk_fp8_f32(v1[0], v1[1], w0.y, false); w0.y = __builtin_amdgcn_cvt_pk_fp8_f32(v1[2], v1[3], w0.y, true); }
                { const f32x4 v0 = acc[ai][1][m][0] * gt, v1 = acc[ai][1][m][1] * gt;
                  w1.x = __builtin_amdgcn_cvt_pk_fp8_f32(v0[0], v0[1], w1.x, false); w1.x = __builtin_amdgcn_cvt_pk_fp8_f32(v0[2], v0[3], w1.x, true);
                  w1.y = __builtin_amdgcn_cvt_pk_fp8_f32(v1[0], v1[1], w1.y, false); w1.y = __builtin_amdgcn_cvt_pk_fp8_f32(v1[2], v1[3], w1.y, true); }
                { const bool od = fq & 1;
                  const unsigned rx = (unsigned)__shfl_xor((int)(od ? w0.x : w1.x), 16), ry = (unsigned)__shfl_xor((int)(od ? w0.y : w1.y), 16);
                  w0.x = od ? rx : w0.x; w1.x = od ? w1.x : rx; w0.y = od ? ry : w0.y; w1.y = od ? w1.y : ry; }
#endif
                if (qq >= 0) { u32x4 o; o.x = w0.x; o.y = w0.y; o.z = w1.x; o.w = w1.y; *(u32x4*)(Y + (size_t)qq * DM + col0) = o; } }
    }
};
}

__device__ __forceinline__ int ph_moe1(CP& p, G8_LAS unsigned char* lds, int e0, int ne) {
    const int* counts = (const int*)(p.ws + WS_CTL + CTL_COUNTS); const int* seg = (const int*)(p.ws + WS_SEG); const int* list = (const int*)(p.ws + WS_LIST);
    g8::MoeOrder S; S.init(p.ws + WS_H2, p.ws + WS_WGU, (size_t)512 * DM * 2, counts, seg, list, (G8_LAS int*)(lds + LDS_TP), DM, 2, e0, ne, gridDim.x, blockIdx.x, false);
    S.pn_major = true; S.Bt1 = (const char*)(p.ws + WS_WGU1A); S.es1 = 128; S.Bt2 = (const char*)(p.ws + WS_WGU1B); S.es2 = 128 + GU1B_FIRST;
    g8::EpiMoe1 E{(bf16_t*)(p.ws + WS_H), seg[e0]};
    g8::gemm_phase<g8::EpiMoe1, g8::MoeOrder, true, true, true>(lds, (G8_LAS unsigned*)(lds + LDS_GSLOT), DM, S, E);
    return S.nwg;
}
__device__ __forceinline__ void ph_moe2(CP& p, G8_LAS unsigned char* lds, int e0, int ne, bool wd1 = false, bool gu1b = false) {
    const int* counts = (const int*)(p.ws + WS_CTL + CTL_COUNTS); const int* seg = (const int*)(p.ws + WS_SEG); const int* list = (const int*)(p.ws + WS_LIST);
    g8::MoeOrder S; S.init(p.ws + WS_H, p.ws + WS_WD, (size_t)DM * DE * 2, counts, seg, list, (G8_LAS int*)(lds + LDS_TP), DE, 4, e0, ne, gridDim.x, blockIdx.x, true);
    S.pn_major = true; S.Bt1 = (const char*)(p.ws + WS_WD1); S.es1 = 128;
    g8::EpiMoe2 E; E.Y = (unsigned char*)(p.ws + WS_Y); E.list = list; E.pg = (const float*)(p.ws + WS_PAIRG);
    g8::gemm_phase<g8::EpiMoe2, g8::MoeOrder, false, true, true>(lds, (G8_LAS unsigned*)(lds + LDS_GSLOT), DE, S, E);
}
__device__ __forceinline__ void d_prep(CP& p, float* lds) {
    const int tid = threadIdx.x, lane = tid & 63, wv = tid >> 6;
    const int gtid = blockIdx.x * NT + tid, gsz = gridDim.x * NT;
    const float* c = p.in[I_C];
    for (int i = tid; i < BATCH * DM; i += NT) lds[i] = siluf_(c[i]);
    __syncthreads();
    float* mod = (float*)(p.ws + WS_MOD);
    const float* wada = p.in[I_WADA]; const float* bada = p.in[I_BADA];
    float* part = lds + BATCH * DM;
    for (int cg = blockIdx.x; cg < 96; cg += gridDim.x) {
        const int j = cg * 64 + lane;
        float acc[BATCH];
#pragma unroll
        for (int b = 0; b < BATCH; ++b) acc[b] = 0.f;
#pragma unroll 8
        for (int k = wv * 128; k < wv * 128 + 128; ++k) { const float w = wada[(size_t)k * 6 * DM + j];
#pragma unroll
            for (int b = 0; b < BATCH; ++b) acc[b] += lds[b * DM + k] * w; }
#pragma unroll
        for (int b = 0; b < BATCH; ++b) part[(wv * BATCH + b) * 64 + lane] = acc[b];
        __syncthreads();
        for (int o = tid; o < BATCH * 64; o += NT) { const int b = o >> 6, l = o & 63; float s = bada[cg * 64 + l];
#pragma unroll
            for (int w = 0; w < 8; ++w) s += part[(w * BATCH + b) * 64 + l];
            mod[b * 6 * DM + cg * 64 + l] = s; }
        __syncthreads();
    }
    float* ab_re = (float*)(p.ws + WS_S5P); float* ab_im = ab_re + 2048; float* bb_re = ab_im + 2048; float* bb_im = bb_re + 32768;
    for (int i = gtid; i < S5_G * S5_N; i += gsz) {
        const int g = i / S5_N;
        const float dt = expf(p.in[I_LOGDT][g]);
        const float lr = p.in[I_LRE][i], li = p.in[I_LIM][i];
        const float mag = expf(lr * dt);
        const float are = mag * cosf(li * dt), aim = mag * sinf(li * dt);
        ab_re[i] = are; ab_im[i] = aim;
        const float den = lr * lr + li * li, nr = are - 1.f;
        const float cre = (nr * lr + aim * li) / den, cim = (aim * lr - nr * li) / den;
        for (int cc = 0; cc < S5_C; ++cc) {
            const float br = p.in[I_BRE][i * S5_C + cc], bi = p.in[I_BIM][i * S5_C + cc];
            bb_re[i * S5_C + cc] = cre * br - cim * bi;
            bb_im[i * S5_C + cc] = cre * bi + cim * br;
        }
    }
    int* list = (int*)(p.ws + WS_LIST);
    for (size_t i = gtid; i < LIST_ENTRIES; i += gsz) list[i] = -1;
    __syncthreads();
}

__device__ __forceinline__ void d_hnorm(CP& p) {
    const int lane = threadIdx.x & 63, gw = (blockIdx.x * NT + threadIdx.x) >> 6, nw = gridDim.x * NT / 64;
    const float* x = p.in[I_X]; const float* g = p.in[I_GMIX]; const float* mod = (const float*)(p.ws + WS_MOD);
    bf16_t* hb = (bf16_t*)(p.ws + WS_HBUF);
    for (int r = gw; r < T; r += nw) {
        const int b = r / SEQ;
        float4 v[4]; float ss = 0.f;
#pragma unroll
        for (int j = 0; j < 4; ++j) { v[j] = *(const float4*)(x + (size_t)r * DM + (j >> 1) * 512 + lane * 8 + (j & 1) * 4); ss += v[j].x * v[j].x + v[j].y * v[j].y + v[j].z * v[j].z + v[j].w * v[j].w; }
        const float rstd = rsqrtf(wave_sum(ss) / DM + EPS);
#pragma unroll
        for (int jj = 0; jj < 2; ++jj) { uint4 o; unsigned ow[4];
#pragma unroll
            for (int q = 0; q < 2; ++q) { const int j = jj * 2 + q, c0 = jj * 512 + lane * 8 + q * 4;
                const float4 gg = *(const float4*)(g + c0), sc = *(const float4*)(mod + b * 6 * DM + DM + c0), sh = *(const float4*)(mod + b * 6 * DM + c0);
                const float h0 = (v[j].x * rstd) * gg.x * (1.f + sc.x) + sh.x, h1 = (v[j].y * rstd) * gg.y * (1.f + sc.y) + sh.y;
                const float h2 = (v[j].z * rstd) * gg.z * (1.f + sc.z) + sh.z, h3 = (v[j].w * rstd) * gg.w * (1.f + sc.w) + sh.w;
                ow[2 * q] = (unsigned)f2bf(h0) | ((unsigned)f2bf(h1) << 16); ow[2 * q + 1] = (unsigned)f2bf(h2) | ((unsigned)f2bf(h3) << 16); }
            o.x = ow[0]; o.y = ow[1]; o.z = ow[2]; o.w = ow[3];
            *(uint4*)(hb + (size_t)r * DM + jj * 512 + lane * 8) = o; }
    }
}

__device__ __forceinline__ void d_s5(CP& p, int blk, int nblk) {
    const int lane = threadIdx.x & 63, wv = threadIdx.x >> 6;
    const bf16_t* proj = (const bf16_t*)(p.ws + WS_PROJ); bf16_t* gb = (bf16_t*)(p.ws + WS_GBUF);
    const float* ab_re = (const float*)(p.ws + WS_S5P); const float* ab_im = ab_re + 2048; const float* bb_re = ab_im + 2048; const float* bb_im = bb_re + 32768;
    for (int item = blk * 8 + wv; item < BATCH * S5_G; item += nblk * 8) {
        const int b = item / S5_G, g = item % S5_G, n = lane;
        const float ar = ab_re[g * 64 + n], ai = ab_im[g * 64 + n];
        float bre[16], bim[16], cre[16], cim[16];
#pragma unroll
        for (int c = 0; c < 16; ++c) { bre[c] = bb_re[(g * 64 + n) * 16 + c]; bim[c] = bb_im[(g * 64 + n) * 16 + c];
            cre[c] = p.in[I_CRE][(g * 16 + c) * 64 + n]; cim[c] = p.in[I_CIM][(g * 16 + c) * 64 + n]; }
        const float dsk = lane < 16 ? p.in[I_S5D][g * 16 + lane] : 0.f;
        float hr = 0.f, hi = 0.f;
        for (int t = 0; t < SEQ; ++t) {
            const size_t row = (size_t)b * SEQ + t;
            const float uval = lane < 16 ? bf2f(proj[row * 2048 + g * 16 + lane]) : 0.f;
            float bur = 0.f, bui = 0.f;
#pragma unroll
            for (int c = 0; c < 16; ++c) { const float uc = __shfl(uval, c); bur += uc * bre[c]; bui += uc * bim[c]; }
            const float nhr = ar * hr - ai * hi + bur, nhi = ar * hi + ai * hr + bui;
            hr = nhr; hi = nhi;
            float yv = 0.f;
#pragma unroll
            for (int c = 0; c < 16; ++c) { const float s = wave_sum(cre[c] * hr - cim[c] * hi); if (lane == c) yv = s; }
            if (lane < 16) { const float y = yv + dsk * uval; gb[row * 512 + g * 16 + lane] = f2bf(gelu_tanh(y)); }
        }
    }
}

__device__ __forceinline__ void d_gla(CP& p, int blk, int nblk, float* lds) {
    float* sa = lds; float* sk = lds + 64; float* sq = lds + 128; float* sv = lds + 192; float* so = lds + 320; float* sred = lds + 832;
    const int tid = threadIdx.x, dv = tid & 127, qd = tid >> 7;
    const bf16_t* proj = (const bf16_t*)(p.ws + WS_PROJ); const float* loga = (const float*)(p.ws + WS_LOGA);
    bf16_t* mix = (bf16_t*)(p.ws + WS_MIX);
    for (int item = blk; item < BATCH * GLA_H; item += nblk) {
        const int b = item / GLA_H, h = item % GLA_H;
        float S[16];
#pragma unroll
        for (int i = 0; i < 16; ++i) S[i] = 0.f;
        for (int t = 0; t < SEQ; ++t) {
            const size_t row = (size_t)b * SEQ + t;
            if (tid < 64) { sa[tid] = expf(loga[row * 256 + h * 64 + tid]); sq[tid] = bf2f(proj[row * 2048 + 512 + h * 64 + tid]); sk[tid] = bf2f(proj[row * 2048 + 768 + h * 64 + tid]); }
            else if (tid < 192) sv[tid - 64] = bf2f(proj[row * 2048 + 1024 + h * 128 + (tid - 64)]);
            __syncthreads();
            float part = 0.f; const float vv = sv[dv];
#pragma unroll
            for (int i = 0; i < 16; ++i) { const int kk = qd * 16 + i; S[i] = sa[kk] * S[i] + sk[kk] * vv; part += sq[kk] * S[i]; }
            so[qd * 128 + dv] = part;
            __syncthreads();
            float o = 0.f;
            if (tid < 128) { o = (so[dv] + so[128 + dv] + so[256 + dv] + so[384 + dv]) * 0.125f; const float ssq = wave_sum(o * o); if ((tid & 63) == 0) sred[tid >> 6] = ssq; }
            __syncthreads();
            if (tid < 128) { const float ms = (sred[0] + sred[1]) / 128.f; const float r = bf2f(proj[row * 2048 + 1536 + h * 128 + dv]);
                const float y = o * rsqrtf(ms + EPS) * p.in[I_GLANG][dv] * siluf_(r); mix[row * DM + 512 + h * 128 + dv] = f2bf(y); }
        }
        __syncthreads();
    }
}

__device__ __forceinline__ void d_h2(CP& p) {
    const int lane = threadIdx.x & 63, gw = (blockIdx.x * NT + threadIdx.x) >> 6, nw = gridDim.x * NT / 64;
    const float* g = p.in[I_GMOE]; const float* mod = (const float*)(p.ws + WS_MOD); const float* rowss2 = (const float*)(p.ws + WS_RSS2);
    bf16_t* h2 = (bf16_t*)(p.ws + WS_H2);
    for (int r = gw; r < T; r += nw) {
        const int b = r / SEQ; float ssq = 0.f;
#pragma unroll
        for (int i = 0; i < 4; ++i) { const float4 q4 = *(const float4*)(rowss2 + (size_t)i * (T * 4) + (size_t)r * 4); ssq += q4.x; ssq += q4.y; ssq += q4.z; ssq += q4.w; }
        const float rstd = rsqrtf(ssq / DM + EPS);
#pragma unroll
        for (int jj = 0; jj < 2; ++jj) { const int cb = jj * 512 + lane * 8;
            const uint4 xw4 = *(const uint4*)((const bf16_t*)(p.ws + WS_X1B) + (size_t)r * DM + cb);
            const unsigned xw[4] = {xw4.x, xw4.y, xw4.z, xw4.w}; unsigned ow[4];
#pragma unroll
            for (int q = 0; q < 2; ++q) { const int c0 = cb + q * 4;
                float4 v; v.x = __uint_as_float(xw[2 * q] << 16); v.y = __uint_as_float(xw[2 * q] & 0xffff0000u); v.z = __uint_as_float(xw[2 * q + 1] << 16); v.w = __uint_as_float(xw[2 * q + 1] & 0xffff0000u);
                const float4 gg = *(const float4*)(g + c0), sc = *(const float4*)(mod + b * 6 * DM + 4 * DM + c0), sh = *(const float4*)(mod + b * 6 * DM + 3 * DM + c0);
                const float h0 = (v.x * rstd) * gg.x * (1.f + sc.x) + sh.x, h1 = (v.y * rstd) * gg.y * (1.f + sc.y) + sh.y;
                const float h2v = (v.z * rstd) * gg.z * (1.f + sc.z) + sh.z, h3 = (v.w * rstd) * gg.w * (1.f + sc.w) + sh.w;
                ow[2 * q] = (unsigned)f2bf(h0) | ((unsigned)f2bf(h1) << 16); ow[2 * q + 1] = (unsigned)f2bf(h2v) | ((unsigned)f2bf(h3) << 16); }
            uint4 o; o.x = ow[0]; o.y = ow[1]; o.z = ow[2]; o.w = ow[3];
            *(uint4*)(h2 + (size_t)r * DM + cb) = o; }
    }
}

__device__ __forceinline__ float rt_sigmoid(float x) { return 1.f / (1.f + __expf(-x)); }
__device__ __forceinline__ void rt_ins8(float (&L)[8], int (&I)[8], float v, int id) {
#pragma unroll
    for (int s = 0; s < 8; ++s) { const bool gt = v > L[s]; const float tv = gt ? L[s] : v; const int ti = gt ? I[s] : id; L[s] = gt ? v : L[s]; I[s] = gt ? id : I[s]; v = tv; id = ti; }
}
__device__ __forceinline__ void d_route(CP& p, float* lds, int nrb, bool dry = false) {
    const float* logits = (const float*)(p.ws + WS_LOGITS); const float* rb = p.in[I_RB];
    int* counts = dry ? (int*)(p.ws + WS_H + 4 * MiB) : (int*)(p.ws + WS_CTL + CTL_COUNTS); int* pair_info = (int*)(p.ws + (dry ? WS_H : WS_PAIRI)); float* pair_gate = (float*)(p.ws + (dry ? WS_H + 2 * MiB : WS_PAIRG));
    constexpr int LR = 257;
    int* hist = (int*)(lds + 128 * LR); int* hbase = hist + NE;
    float* gsl = (float*)(hbase + NE);
    const int tk = threadIdx.x >> 2, sub = threadIdx.x & 3;
    for (int t0 = blockIdx.x * 128; t0 < T; t0 += nrb * 128) {
        __syncthreads();
#pragma unroll 4
        for (int i = 0; i < 16; ++i) { const int idx = threadIdx.x + i * NT; const int tkk = idx >> 6, c4 = idx & 63;
            const float4 v = *(const float4*)(logits + (size_t)(t0 + tkk) * 256 + c4 * 4);
            float* d = lds + tkk * LR + c4 * 4; d[0] = v.x; d[1] = v.y; d[2] = v.z; d[3] = v.w; }
        if (threadIdx.x < NE) hist[threadIdx.x] = 0;
        __syncthreads();
        const float* lg = lds + tk * LR;
#pragma unroll
        for (int gg = 0; gg < 2; ++gg) { const int g = 2 * sub + gg; float m1 = -INFINITY, m2 = -INFINITY;
#pragma unroll 8
            for (int i = 0; i < 32; ++i) { const float b0 = rt_sigmoid(lg[g * 32 + i]) + rb[g * 32 + i]; m2 = fmaxf(m2, fminf(m1, b0)); m1 = fmaxf(m1, b0); }
            gsl[tk * 8 + g] = m1 + m2; }
        __syncthreads();
        float gs[8];
#pragma unroll
        for (int g = 0; g < 8; ++g) gs[g] = gsl[tk * 8 + g];
        unsigned selmask = 0u;
#pragma unroll
        for (int a = 0; a < 8; ++a) { int rank = 0;
#pragma unroll
            for (int c = 0; c < 8; ++c) rank += (gs[c] > gs[a] || (gs[c] == gs[a] && c < a)) ? 1 : 0;
            if (rank < 4) selmask |= 1u << a; }
        unsigned rem = selmask;
        for (int k = 0; k < sub; ++k) rem &= rem - 1u;
        const int g = __builtin_ctz(rem);
        float L[8]; int I[8];
#pragma unroll
        for (int s = 0; s < 8; ++s) { L[s] = -INFINITY; I[s] = 0; }
#pragma unroll 4
        for (int i = 0; i < 32; ++i) rt_ins8(L, I, rt_sigmoid(lg[g * 32 + i]) + rb[g * 32 + i], g * 32 + i);
        const unsigned uns = (~selmask) & 0xffu; const int u0 = __builtin_ctz(uns), u1 = __builtin_ctz(uns & (uns - 1u));
        float* park = lds + tk * LR;
        { float* d = park + (sub < 2 ? u0 : u1) * 32 + (sub & 1) * 16;
#pragma unroll
          for (int s = 0; s < 8; ++s) { d[s] = L[s]; d[8 + s] = __int_as_float(I[s]); } }
        __syncthreads();
        float sc[8]; int lrank[8]; float inv = 0.f;
        if (sub == 0) {
#pragma unroll 1
            for (int q = 1; q < 4; ++q) { const float* d = park + (q < 2 ? u0 : u1) * 32 + (q & 1) * 16;
#pragma unroll
                for (int s = 0; s < 8; ++s) rt_ins8(L, I, d[s], __float_as_int(d[8 + s])); }
            float ssum = 0.f;
#pragma unroll
            for (int s = 0; s < 8; ++s) { sc[s] = rt_sigmoid(lg[I[s]]); ssum += sc[s]; }
            inv = ROUTED_SCALE / ssum;
#pragma unroll
            for (int s = 0; s < 8; ++s) lrank[s] = atomicAdd(&hist[I[s]], 1);
        }
        __syncthreads();
        if (threadIdx.x < NE) { const int c = hist[threadIdx.x]; hbase[threadIdx.x] = c ? atomicAdd(&counts[threadIdx.x * CNT_STRIDE], c) : 0; }
        __syncthreads();
        if (sub == 0) { const int t = t0 + tk;
#pragma unroll
            for (int s = 0; s < 8; ++s) { const int rank = hbase[I[s]] + lrank[s]; pair_info[t * 8 + s] = I[s] | (rank << 8); pair_gate[t * 8 + s] = sc[s] * inv; } }
    }
    __syncthreads();
}
__device__ __forceinline__ void d_seglist(CP& p, int* seg_lds) {
    const int* counts = (const int*)(p.ws + WS_CTL + CTL_COUNTS); int* seg = (int*)(p.ws + WS_SEG);
    if (threadIdx.x < NE) seg_lds[260 + threadIdx.x] = (counts[threadIdx.x * CNT_STRIDE] + 255) / 256 * 256;
    __syncthreads();
    if (threadIdx.x == 0) { int s = 0; for (int e = 0; e < NE; ++e) { seg_lds[e] = s; s += seg_lds[260 + e]; } seg_lds[NE] = s; }
    __syncthreads();
    if (blockIdx.x == 0) for (int e = threadIdx.x; e <= NE; e += NT) seg[e] = seg_lds[e];
    const int* pi = (const int*)(p.ws + WS_PAIRI); int* list = (int*)(p.ws + WS_LIST);
    for (int q = blockIdx.x * NT + threadIdx.x; q < NPAIR; q += gridDim.x * NT) { const int v = pi[q]; __hip_atomic_store(&list[seg_lds[v & 255] + (v >> 8)], q, __ATOMIC_RELAXED, __HIP_MEMORY_SCOPE_AGENT); }
    __syncthreads();
}

__device__ __forceinline__ void d_final(CP& p, bool dry = false, float* lds = nullptr) {
    const int lane = threadIdx.x & 63, gw = (blockIdx.x * NT + threadIdx.x) >> 6, nw = gridDim.x * NT / 64;
    const unsigned char* Y = (const unsigned char*)(p.ws + WS_Y); const unsigned char* Ys = (const unsigned char*)(p.ws + WS_YSH); const float* mod = (const float*)(p.ws + WS_MOD); const float* gf = p.in[I_GFIN];
    float* wl = lds + (threadIdx.x >> 6) * 1024;
    const int c0 = lane * 16;
    for (int r = gw; r < T; r += nw) {
        const int b = r / SEQ;
        float yr[16];
#pragma unroll
        for (int i = 0; i < 16; ++i) yr[i] = 0.f;
#if defined(__HIP_DEVICE_COMPILE__)
#pragma unroll
        for (int k = 0; k < 9; ++k) { const uint4 w = *(const uint4*)(k < 8 ? Y + ((size_t)r * 8 + k) * DM + c0 : Ys + (size_t)r * DM + c0);
            const unsigned ww[4] = {w.x, w.y, w.z, w.w};
#pragma unroll
            for (int q = 0; q < 4; ++q) { const auto a0 = __builtin_amdgcn_cvt_pk_f32_fp8(ww[q], false), a1 = __builtin_amdgcn_cvt_pk_f32_fp8(ww[q], true);
                yr[q * 4 + 0] += a0[0]; yr[q * 4 + 1] += a0[1]; yr[q * 4 + 2] += a1[0]; yr[q * 4 + 3] += a1[1]; } }
#endif
        const uint4 xa = *(const uint4*)((const bf16_t*)(p.ws + WS_X1B) + (size_t)r * DM + c0), xb = *(const uint4*)((const bf16_t*)(p.ws + WS_X1B) + (size_t)r * DM + c0 + 8);
        const unsigned xw[8] = {xa.x, xa.y, xa.z, xa.w, xb.x, xb.y, xb.z, xb.w};
        float ss = 0.f;
#pragma unroll
        for (int q = 0; q < 4; ++q) { const float4 g4 = *(const float4*)(mod + b * 6 * DM + 5 * DM + c0 + 4 * q);
            const float x0 = __uint_as_float(xw[2 * q] << 16), x1 = __uint_as_float(xw[2 * q] & 0xffff0000u), x2 = __uint_as_float(xw[2 * q + 1] << 16), x3 = __uint_as_float(xw[2 * q + 1] & 0xffff0000u);
            float4 v; v.x = x0 + g4.x * (yr[4 * q + 0] * (1.f / 16.f)); v.y = x1 + g4.y * (yr[4 * q + 1] * (1.f / 16.f));
            v.z = x2 + g4.z * (yr[4 * q + 2] * (1.f / 16.f)); v.w = x3 + g4.w * (yr[4 * q + 3] * (1.f / 16.f));
            ss += v.x * v.x; ss += v.y * v.y; ss += v.z * v.z; ss += v.w * v.w;
            *(float4*)(wl + c0 + 4 * q) = v; }
        const float rstd = rsqrtf(wave_sum(ss) / DM + EPS);
        float* dst = dry ? (float*)(p.ws + WS_H) : p.out;
#pragma unroll
        for (int s = 0; s < 4; ++s) { const int cq = 4 * (lane + 64 * s); const float4 v = *(const float4*)(wl + cq), f4 = *(const float4*)(gf + cq); float4 o;
            o.x = v.x * rstd * f4.x; o.y = v.y * rstd * f4.y; o.z = v.z * rstd * f4.z; o.w = v.w * rstd * f4.w;
            *(float4*)(dst + (size_t)r * DM + cq) = o; }
    }
}
namespace mx {
typedef short bf16x8 __attribute__((ext_vector_type(8)));
typedef short bf16x4 __attribute__((ext_vector_type(4)));
typedef float f32x4 __attribute__((ext_vector_type(4)));
typedef float f32x16 __attribute__((ext_vector_type(16)));
typedef unsigned u32x2 __attribute__((ext_vector_type(2)));
typedef unsigned u32x4 __attribute__((ext_vector_type(4)));
__device__ __forceinline__ unsigned pk2(float lo, float hi) { unsigned r; asm("v_cvt_pk_bf16_f32 %0, %1, %2" : "=v"(r) : "v"(lo), "v"(hi)); return r; }
__device__ __forceinline__ float fast_gelu(float x) { const float u = 0.7978845608028654f * (x + 0.044715f * x * x * x); const float e = __expf(2.f * u); const float th = 1.f - 2.f * __builtin_amdgcn_rcpf(1.f + e); return 0.5f * x * (1.f + th); }
__device__ __forceinline__ float fast_silu(float x) { return x * __builtin_amdgcn_rcpf(1.f + __expf(-x)); }

__device__ __forceinline__ void s5_item(CP& p, int item, G8_LAS unsigned char* wl) {
    const int lane = threadIdx.x & 63, r = lane & 31, hh = lane >> 5, c16 = lane & 15, q16 = lane >> 4;
    const int b = item / S5_G, g = item % S5_G;
    const bf16_t* proj = (const bf16_t*)(p.ws + WS_PROJ); bf16_t* gb = (bf16_t*)(p.ws + WS_GBUF);
    const float* ab_re = (const float*)(p.ws + WS_S5P); const float* ab_im = ab_re + 2048; const float* bb_re = ab_im + 2048; const float* bb_im = bb_re + 32768;
    bf16x8 bbf[4];
#pragma unroll
    for (int j = 0; j < 4; ++j) { const float* src = (j < 2 ? bb_re : bb_im) + ((size_t)(g * 64 + 32 * (j & 1) + r)) * 16 + 8 * hh;
#pragma unroll
        for (int jj = 0; jj < 8; ++jj) bbf[j][jj] = (short)f2bf(src[jj]); }
    bf16x8 cf[4];
#pragma unroll
    for (int s = 0; s < 4; ++s)
#pragma unroll
        for (int jj = 0; jj < 8; ++jj) { const int k = 32 * s + 8 * q16 + jj; const float v = k < 64 ? p.in[I_CRE][(g * 16 + c16) * 64 + k] : -p.in[I_CIM][(g * 16 + c16) * 64 + (k - 64)]; cf[s][jj] = (short)f2bf(v); }
    const float ar = ab_re[g * 64 + lane], ai = ab_im[g * 64 + lane];
    const float dsk = p.in[I_S5D][g * 16 + c16];
    G8_LAS bf16_t* Hl = (G8_LAS bf16_t*)wl; G8_LAS bf16_t* Ul = (G8_LAS bf16_t*)(wl + 32 * 272);
    float hr = 0.f, hi = 0.f;
    const size_t rowb = (size_t)b * SEQ;
    bf16x8 ufrag = *(const bf16x8*)(proj + (rowb + r) * 2048 + g * 16 + 8 * hh);
    unsigned short yout[8];
#pragma unroll
    for (int i = 0; i < 8; ++i) yout[i] = 0;
    for (int ch = 0; ch < SEQ / 32; ++ch) {
        const int t0 = ch * 32;
        const bf16x8 uf = ufrag;
        if (ch + 1 < SEQ / 32) ufrag = *(const bf16x8*)(proj + (rowb + t0 + 32 + r) * 2048 + g * 16 + 8 * hh);
        if (ch > 0) {
#pragma unroll
            for (int tt = 0; tt < 2; ++tt)
#pragma unroll
                for (int rg = 0; rg < 4; ++rg) gb[(rowb + t0 - 32 + 16 * tt + 4 * q16 + rg) * 512 + g * 16 + c16] = yout[tt * 4 + rg]; }
        *(G8_LAS bf16x8*)(Ul + r * 16 + 8 * hh) = uf;
        f32x16 acc[4];
#pragma unroll
        for (int j = 0; j < 4; ++j) { f32x16 z;
#pragma unroll
            for (int i = 0; i < 16; ++i) z[i] = 0.f;
            acc[j] = __builtin_amdgcn_mfma_f32_32x32x16_bf16(uf, bbf[j], z, 0, 0, 0); }
#pragma unroll
        for (int i = 0; i < 16; ++i) {
            { const float a = acc[0][i], bq = acc[1][i]; const float rr = __shfl_xor(hh ? a : bq, 32); acc[0][i] = hh ? rr : a; acc[1][i] = hh ? bq : rr; }
            { const float a = acc[2][i], bq = acc[3][i]; const float rr = __shfl_xor(hh ? a : bq, 32); acc[2][i] = hh ? rr : a; acc[3][i] = hh ? bq : rr; }
        }
#pragma unroll
        for (int t = 0; t < 32; ++t) { const int sel = (t >> 2) & 1, i = (t & 3) + 4 * (t >> 3);
            const float bur = acc[sel][i], bui = acc[2 + sel][i];
            const float nhr = fmaf(ar, hr, fmaf(-ai, hi, bur)), nhi = fmaf(ar, hi, fmaf(ai, hr, bui));
            hr = nhr; hi = nhi;
            const unsigned hp = pk2(hr, hi); Hl[t * 136 + lane] = (bf16_t)hp; Hl[t * 136 + 64 + lane] = (bf16_t)(hp >> 16); }
        f32x4 ya[2];
#pragma unroll
        for (int tt = 0; tt < 2; ++tt) { ya[tt] = (f32x4){0.f, 0.f, 0.f, 0.f};
#pragma unroll
            for (int s = 0; s < 4; ++s) { const bf16x8 af = *(const G8_LAS bf16x8*)(Hl + (16 * tt + c16) * 136 + 32 * s + 8 * q16);
                ya[tt] = __builtin_amdgcn_mfma_f32_16x16x32_bf16(af, cf[s], ya[tt], 0, 0, 0); } }
#pragma unroll
        for (int tt = 0; tt < 2; ++tt)
#pragma unroll
            for (int rg = 0; rg < 4; ++rg) { const int t = 16 * tt + 4 * q16 + rg; const float u = bf2f(Ul[t * 16 + c16]);
                const float y = ya[tt][rg] + dsk * u; yout[tt * 4 + rg] = f2bf(fast_gelu(y)); }
    }
#pragma unroll
    for (int tt = 0; tt < 2; ++tt)
#pragma unroll
        for (int rg = 0; rg < 4; ++rg) gb[(rowb + SEQ - 32 + 16 * tt + 4 * q16 + rg) * 512 + g * 16 + c16] = yout[tt * 4 + rg];
}

constexpr int G_QI = 0, G_KI = 9216, G_P = 18432, G_V = 27648, G_ST = 45056, G_TOT = 63488, G_DEC = 65536, G_RS = 65792, G_R0 = 66816  , G_Y = 101632  , G_END = 119040;
__device__ __forceinline__ bf16x4 tr_read4(unsigned a) {
#if defined(__HIP_DEVICE_COMPILE__)
    return __builtin_amdgcn_ds_read_tr16_b64_v4i16((G8_LAS bf16x4*)(size_t)a);
#else
    return bf16x4{};
#endif
}
__device__ __forceinline__ bf16x8 cat8(bf16x4 a, bf16x4 b) { bf16x8 o; o[0] = a[0]; o[1] = a[1]; o[2] = a[2]; o[3] = a[3]; o[4] = b[0]; o[5] = b[1]; o[6] = b[2]; o[7] = b[3]; return o; }
#define MX_TR_ADDR(base, RSB, ks, col0, t) ((base) + (unsigned)((16 * (ks) + 8 * hh + 4 * (t) + ((lane & 15) >> 2)) * (RSB) + ((col0) + 16 * ((lane >> 4) & 1) + 4 * (lane & 3)) * 2))

__device__ __forceinline__ void gla_item(CP& p, int item, G8_LAS unsigned char* lds) {
    const int tid = threadIdx.x, lane = tid & 63, w = __builtin_amdgcn_readfirstlane(tid >> 6), r = lane & 31, hh = lane >> 5;
    const int b = item / GLA_H, h = item % GLA_H;
    const bf16_t* proj = (const bf16_t*)(p.ws + WS_PROJ); const float* loga = (const float*)(p.ws + WS_LOGA); bf16_t* mix = (bf16_t*)(p.ws + WS_MIX);
    const unsigned lbase = (unsigned)(size_t)lds;
    G8_LAS bf16_t* QI = (G8_LAS bf16_t*)(lds + G_QI); G8_LAS bf16_t* KI = (G8_LAS bf16_t*)(lds + G_KI); G8_LAS bf16_t* Pm = (G8_LAS bf16_t*)(lds + G_P);
    G8_LAS bf16_t* Vm = (G8_LAS bf16_t*)(lds + G_V); G8_LAS bf16_t* ST = (G8_LAS bf16_t*)(lds + G_ST);
    G8_LAS float* TOT = (G8_LAS float*)(lds + G_TOT); G8_LAS float* DEC = (G8_LAS float*)(lds + G_DEC); G8_LAS float* RS = (G8_LAS float*)(lds + G_RS);
    const int c = lane, sg = w;
    const int tv = tid >> 3, vg = tid & 7;
    const int dvt = w & 3, tt = w >> 2;
    const int di = w >> 2, dj = w & 3;
    const int si = (w == 2) ? 1 : 0, ti = (w == 0) ? 0 : 1;
    f32x16 S;
#pragma unroll
    for (int i = 0; i < 16; ++i) S[i] = 0.f;
    for (int i = tid; i < 128 * 72 / 2; i += NT) ((G8_LAS unsigned*)ST)[i] = 0u;
    const size_t rowb = (size_t)b * SEQ;
    struct Stage { float la[8]; u32x4 q16, k16, v0, v1, r0, r1; };
    Stage stA; G8_LAS bf16_t* Yim = (G8_LAS bf16_t*)(lds + G_Y);
    float4 ngc[4];
#pragma unroll
    for (int q4 = 0; q4 < 4; ++q4) ngc[q4] = *(const float4*)(p.in[I_GLANG] + 32 * dvt + 8 * q4 + 4 * hh);
#define MX_LOAD_CHUNK(st, n_) do { const size_t r0_ = rowb + (size_t)(n_) * 64; \
        _Pragma("unroll") for (int i = 0; i < 8; ++i) { const size_t rr = r0_ + sg * 8 + i; st.la[i] = loga[rr * 256 + h * 64 + c]; } \
        st.q16 = *(const u32x4*)(proj + (r0_ + tv) * 2048 + 512 + h * 64 + vg * 8); st.k16 = *(const u32x4*)(proj + (r0_ + tv) * 2048 + 768 + h * 64 + vg * 8); \
        st.v0 = *(const u32x4*)(proj + (r0_ + tv) * 2048 + 1024 + h * 128 + vg * 16); st.v1 = *(const u32x4*)(proj + (r0_ + tv) * 2048 + 1024 + h * 128 + vg * 16 + 8); \
        st.r0 = *(const u32x4*)(proj + (r0_ + tv) * 2048 + 1536 + h * 128 + vg * 16); st.r1 = *(const u32x4*)(proj + (r0_ + tv) * 2048 + 1536 + h * 128 + vg * 16 + 8); } while (0)
    MX_LOAD_CHUNK(stA, 0);
    auto chunk = [&](const int n, Stage& st) __attribute__((always_inline)) {
        const size_t row0 = rowb + (size_t)n * 64;
        G8_LAS bf16_t* Rim = (G8_LAS bf16_t*)(lds + G_R0 + (n & 1) * 17408);
        float cs[8]; { float a = 0.f;
#pragma unroll
            for (int i = 0; i < 8; ++i) { a += st.la[i]; cs[i] = a; } }
        TOT[sg * 64 + c] = cs[7];
        *(G8_LAS u32x4*)(QI + tv * 72 + vg * 8) = st.q16; *(G8_LAS u32x4*)(KI + tv * 72 + vg * 8) = st.k16;
        *(G8_LAS u32x4*)(Vm + tv * 136 + vg * 16) = st.v0; *(G8_LAS u32x4*)(Vm + tv * 136 + vg * 16 + 8) = st.v1;
        *(G8_LAS u32x4*)(Rim + tv * 136 + vg * 16) = st.r0; *(G8_LAS u32x4*)(Rim + tv * 136 + vg * 16 + 8) = st.r1;
        __syncthreads();
        float pre = 0.f, tot = 0.f;
#pragma unroll
        for (int s = 0; s < 8; ++s) { const float tv_ = TOT[s * 64 + c]; tot += tv_; if (s < sg) pre += tv_; }
#pragma unroll
        for (int i = 0; i < 8; ++i) { const float bc = pre + cs[i]; const float e1 = __expf(bc), e2 = __expf(-bc); const int t = sg * 8 + i;
            const unsigned qk = pk2(bf2f(QI[t * 72 + c]) * e1 * 0.125f, bf2f(KI[t * 72 + c]) * e2); QI[t * 72 + c] = (bf16_t)qk; KI[t * 72 + c] = (bf16_t)(qk >> 16); }
        if (sg == 0) DEC[c] = __expf(tot);
        __syncthreads();
        if (n + 1 < SEQ / 64) MX_LOAD_CHUNK(st, n + 1);
        if (n > 0) {
            const u32x4 y0 = *(const G8_LAS u32x4*)(Yim + tv * 136 + vg * 16), y1 = *(const G8_LAS u32x4*)(Yim + tv * 136 + vg * 16 + 8);
            *(u32x4*)(mix + (row0 - 64 + tv) * DM + 512 + h * 128 + vg * 16) = y0; *(u32x4*)(mix + (row0 - 64 + tv) * DM + 512 + h * 128 + vg * 16 + 8) = y1; }
        if (w < 3) {
            f32x16 sc;
#pragma unroll
            for (int i = 0; i < 16; ++i) sc[i] = 0.f;
#pragma unroll
            for (int kk = 0; kk < 4; ++kk) { const bf16x8 af = *(const G8_LAS bf16x8*)(KI + (32 * si + r) * 72 + 16 * kk + 8 * hh); const bf16x8 bf = *(const G8_LAS bf16x8*)(QI + (32 * ti + r) * 72 + 16 * kk + 8 * hh);
                sc = __builtin_amdgcn_mfma_f32_32x32x16_bf16(af, bf, sc, 0, 0, 0); }
            const int tg = 32 * ti + r;
#pragma unroll
            for (int q4 = 0; q4 < 4; ++q4) { const int s0 = 32 * si + 8 * q4 + 4 * hh; float v[4];
#pragma unroll
                for (int j = 0; j < 4; ++j) v[j] = (s0 + j <= tg) ? sc[4 * q4 + j] : 0.f;
                u32x2 o; o.x = pk2(v[0], v[1]); o.y = pk2(v[2], v[3]); *(G8_LAS u32x2*)(Pm + tg * 72 + s0) = o; }
        }
        f32x16 oa;
#pragma unroll
        for (int i = 0; i < 16; ++i) oa[i] = 0.f;
#pragma unroll
        for (int kk = 0; kk < 4; ++kk) { const bf16x8 af = *(const G8_LAS bf16x8*)(ST + (32 * dvt + r) * 72 + 16 * kk + 8 * hh); const bf16x8 bf = *(const G8_LAS bf16x8*)(QI + (32 * tt + r) * 72 + 16 * kk + 8 * hh);
            oa = __builtin_amdgcn_mfma_f32_32x32x16_bf16(af, bf, oa, 0, 0, 0); }
        bf16x4 vb0[4], vb1[4];
        {
            bf16x4 a0[4], a1[4]; bf16x4 (&b0)[4] = vb0; bf16x4 (&b1)[4] = vb1;
#pragma unroll
            for (int ks = 0; ks < 4; ++ks) { a0[ks] = tr_read4(MX_TR_ADDR(lbase + G_KI, 144, ks, 32 * di, 0)); a1[ks] = tr_read4(MX_TR_ADDR(lbase + G_KI, 144, ks, 32 * di, 1));
                b0[ks] = tr_read4(MX_TR_ADDR(lbase + G_V, 272, ks, 32 * dj, 0)); b1[ks] = tr_read4(MX_TR_ADDR(lbase + G_V, 272, ks, 32 * dj, 1)); }
#pragma unroll
            for (int ks = 0; ks < 4; ++ks) S = __builtin_amdgcn_mfma_f32_32x32x16_bf16(cat8(a0[ks], a1[ks]), cat8(b0[ks], b1[ks]), S, 0, 0, 0);
#pragma unroll
            for (int q4 = 0; q4 < 4; ++q4) { const f32x4 d4 = *(const G8_LAS f32x4*)(DEC + 32 * di + 8 * q4 + 4 * hh);
#pragma unroll
                for (int j = 0; j < 4; ++j) S[4 * q4 + j] *= d4[j]; }
        }
        __syncthreads();
        {
            const int nks = tt ? 4 : 2;
            bf16x4 (&a0)[4] = vb0; bf16x4 (&a1)[4] = vb1;
#pragma unroll
            for (int ks = 0; ks < 4; ++ks) if (ks < nks) { const bf16x8 bf = *(const G8_LAS bf16x8*)(Pm + (32 * tt + r) * 72 + 16 * ks + 8 * hh);
                oa = __builtin_amdgcn_mfma_f32_32x32x16_bf16(cat8(a0[ks], a1[ks]), bf, oa, 0, 0, 0); }
        }
#pragma unroll
        for (int q4 = 0; q4 < 4; ++q4) { u32x2 o; o.x = pk2(S[4 * q4], S[4 * q4 + 1]); o.y = pk2(S[4 * q4 + 2], S[4 * q4 + 3]); *(G8_LAS u32x2*)(ST + (32 * dj + r) * 72 + 32 * di + 8 * q4 + 4 * hh) = o; }
        float ssq = 0.f;
#pragma unroll
        for (int i = 0; i < 16; ++i) ssq += oa[i] * oa[i];
        ssq += __shfl_xor(ssq, 32);
        if (hh == 0) RS[(32 * tt + r) * 4 + dvt] = ssq;
        __syncthreads();
        const f32x4 rs4 = *(const G8_LAS f32x4*)(RS + (32 * tt + r) * 4);
        const float rstd = rsqrtf((rs4[0] + rs4[1] + rs4[2] + rs4[3]) * (1.f / 128.f) + EPS);
#pragma unroll
        for (int q4 = 0; q4 < 4; ++q4) { const float4 ng = ngc[q4];
            const u32x2 rgq = *(const G8_LAS u32x2*)(Rim + (32 * tt + r) * 136 + 32 * dvt + 8 * q4 + 4 * hh);
            const float r0 = __uint_as_float(rgq.x << 16), r1 = __uint_as_float(rgq.x & 0xffff0000u), r2 = __uint_as_float(rgq.y << 16), r3 = __uint_as_float(rgq.y & 0xffff0000u);
            const float y0 = oa[4 * q4] * rstd * ng.x * fast_silu(r0), y1 = oa[4 * q4 + 1] * rstd * ng.y * fast_silu(r1), y2 = oa[4 * q4 + 2] * rstd * ng.z * fast_silu(r2), y3 = oa[4 * q4 + 3] * rstd * ng.w * fast_silu(r3);
            u32x2 yo; yo.x = pk2(y0, y1); yo.y = pk2(y2, y3); *(G8_LAS u32x2*)(Yim + (32 * tt + r) * 136 + 32 * dvt + 8 * q4 + 4 * hh) = yo; }
    };
    for (int n2 = 0; n2 < SEQ / 64; ++n2) chunk(n2, stA);
    __syncthreads();
    { const u32x4 y0 = *(const G8_LAS u32x4*)(Yim + tv * 136 + vg * 16), y1 = *(const G8_LAS u32x4*)(Yim + tv * 136 + vg * 16 + 8);
      *(u32x4*)(mix + (rowb + SEQ - 64 + tv) * DM + 512 + h * 128 + vg * 16) = y0; *(u32x4*)(mix + (rowb + SEQ - 64 + tv) * DM + 512 + h * 128 + vg * 16 + 8) = y1; }
    __syncthreads();
#undef MX_LOAD_CHUNK
}
}
#define XB_TMO      128
#define XB_XCNT(j)  (256  + 64 * (j))
#define XB_XSUB(j)  (1280 + 64 * (j))
#define XB_XGEN(j)  (2304 + 64 * (j))
#define XB_TOP      3328
#define XB_TOPGEN   3392
#define XCD_BAR_WORDS 3456
#define XB_SPIN_CAP (1u << 18)
__device__ __forceinline__ unsigned xb_ld(unsigned* p)              { return __hip_atomic_load(p, __ATOMIC_RELAXED, __HIP_MEMORY_SCOPE_AGENT); }
__device__ __forceinline__ unsigned xb_add(unsigned* p, unsigned v) { return __hip_atomic_fetch_add(p, v, __ATOMIC_RELAXED, __HIP_MEMORY_SCOPE_AGENT); }
__device__ __forceinline__ unsigned xb_xcc_id() { return (unsigned)__builtin_amdgcn_s_getreg((3 << 11) | 20) & 0xFu; }
#define XB_SPIN(cond, bar) do { unsigned _sp = 0; while (cond) { __builtin_amdgcn_s_sleep(1); \
    if ((++_sp & 255u) == 0u) { if (xb_ld(&(bar)[XB_TMO])) break; if (_sp > XB_SPIN_CAP) { atomicAdd(&(bar)[XB_TMO], 1u); break; } } } } while (0)
struct XcdBarrier { unsigned* bar; unsigned x; volatile G8_LAS unsigned* st; };
__device__ __forceinline__ XcdBarrier xcd_barrier_post(unsigned* bar, volatile G8_LAS unsigned* st) {
    XcdBarrier b; b.bar = bar; b.x = xb_xcc_id(); b.st = st;
    if (threadIdx.x == 0) (void)xb_add(&bar[XB_XCNT(b.x)], 1u);
    return b;
}
__device__ __forceinline__ void xcd_barrier_complete(unsigned* bar, unsigned x, unsigned& nloc, unsigned& nx) {
    const unsigned G = gridDim.x * gridDim.y * gridDim.z;
    unsigned sum, cnt, mine, sp = 0u;
    for (;;) {
        sum = 0u; cnt = 0u; mine = 0u;
#pragma unroll
        for (unsigned j = 0; j < 16; ++j) { const unsigned c = xb_ld(&bar[XB_XCNT(j)]); sum += c; cnt += (c > 0u) ? 1u : 0u; mine = (j == x) ? c : mine; }
        if (sum == G) break;
        __builtin_amdgcn_s_sleep(1);
        if ((++sp & 255u) == 0u) { if (xb_ld(&bar[XB_TMO])) break; if (sp > XB_SPIN_CAP) { atomicAdd(&bar[XB_TMO], 1u); break; } }
    }
    nloc = mine > 0u ? mine : 1u; nx = cnt > 0u ? cnt : 1u;
}
__device__ __forceinline__ void xcd_barrier(const XcdBarrier& b) {
    asm volatile("s_waitcnt vmcnt(0)" ::: "memory");
    __syncthreads();
    if (threadIdx.x == 0) {
        unsigned* bar = b.bar;
        __builtin_amdgcn_s_waitcnt(0);
        unsigned nloc = b.st[0], nx = b.st[1];
        if (nloc == 0u) { xcd_barrier_complete(bar, b.x, nloc, nx); b.st[0] = nloc; b.st[1] = nx; }
        const unsigned old = xb_add(&bar[XB_XSUB(b.x)], 1u);
        const unsigned gen = old / nloc;
        if (old + 1u == (gen + 1u) * nloc) {
            __builtin_amdgcn_fence(__ATOMIC_RELEASE, "agent");
            asm volatile("s_waitcnt vmcnt(0)" ::: "memory");
            const unsigned og = xb_add(&bar[XB_TOP], 1u);
            const unsigned tg = og / nx;
            if (og + 1u == (tg + 1u) * nx) xb_add(&bar[XB_TOPGEN], 1u);
            else XB_SPIN(xb_ld(&bar[XB_TOPGEN]) == tg, bar);
            __builtin_amdgcn_fence(__ATOMIC_ACQUIRE, "agent");
            xb_add(&bar[XB_XGEN(b.x)], 1u);
            asm volatile("s_waitcnt vmcnt(0)" ::: "memory");
        } else {
            XB_SPIN(xb_ld(&bar[XB_XGEN(b.x)]) == gen, bar);
            __builtin_amdgcn_fence(__ATOMIC_ACQUIRE, "agent");
            asm volatile("s_waitcnt vmcnt(0)" ::: "memory");
        }
    }
    __syncthreads();
}

constexpr int D1_TAIL = 6;
constexpr int GU1A_EARLY = 1920;
constexpr int CONV_SPLIT = 5440;
__device__ __forceinline__ CP& kargs() { CP* q = (CP*)__builtin_amdgcn_kernarg_segment_ptr(); asm volatile("" : "+s"(q)); return *q; }
constexpr int LDS_SEG = LDS_TP + 2304;
constexpr int LDS_MISC = LDS_SEG + 3072;
static_assert(LDS_MISC + 64 <= LDS_TOTAL, "LDS map");

__global__ void __launch_bounds__(NT, 2) mega(P p) {
    extern __shared__ __attribute__((aligned(16))) unsigned char lds_raw[];
    G8_LAS unsigned char* lds = (G8_LAS unsigned char*)lds_raw;
    volatile G8_LAS unsigned* misc = (volatile G8_LAS unsigned*)(lds + LDS_MISC);
    if (threadIdx.x < 16) misc[threadIdx.x] = 0u;
    __syncthreads();
#define PH kargs()
    XcdBarrier bar = xcd_barrier_post((unsigned*)(PH.ws + WS_CTL + CTL_BAR), misc);
    float* ldsf = (float*)lds_raw;
    int* seg_lds = (int*)(lds_raw + LDS_SEG);

    if (blockIdx.x >= 96) { int tid = threadIdx.x; asm volatile("" : "+v"(tid)); const uint4* src = (const uint4*)PH.in[I_EWG] + (size_t)(blockIdx.x - 96) * 26624; unsigned acc_ = 0;
#pragma unroll 4
      for (int i = 0; i < 52; ++i) { const uint4 v = src[i * NT + tid]; acc_ += v.x ^ v.y ^ v.z ^ v.w; }
      asm volatile("" :: "v"(acc_)); }
    d_prep(PH, ldsf);
    conv_small(PH, blockIdx.x, gridDim.x, ldsf);
    xcd_barrier(bar);
    d_hnorm(PH);
    xcd_barrier(bar);
    ph_inproj(PH, lds);
    xcd_barrier(bar);
    if (blockIdx.x < 64) mx::gla_item(PH, blockIdx.x, lds);
    else if (blockIdx.x < 128) { const int wv_ = __builtin_amdgcn_readfirstlane(threadIdx.x >> 6); mx::s5_item(PH, (blockIdx.x - 64) * 8 + wv_, lds + wv_ * 10240);
        __syncthreads(); conv_experts(PH, 0, 128, true, true, blockIdx.x - 64, 64, ldsf, CONV_SPLIT, 1 << 30); }
    else { conv_experts(PH, 0, 128, true, true, blockIdx.x - 128, gridDim.x - 128, ldsf, 0, CONV_SPLIT);
           conv_experts(PH, 128, 128, false, true, blockIdx.x - 128, gridDim.x - 128, ldsf, 0, 1 << 30, true);
           }
    xcd_barrier(bar);
    ph_glu(PH, lds);
    xcd_barrier(bar);
    ph_wout(PH, lds);
    xcd_barrier(bar);
    d_h2(PH);
    xcd_barrier(bar);
    if (blockIdx.x < 192) ph_rs(PH, lds, 192);
    else conv_experts(PH, 128 + GU1B_FIRST, 128 - GU1B_FIRST, true, false, blockIdx.x - 192, gridDim.x - 192, ldsf, 0, 1 << 30, false, true);
    xcd_barrier(bar);
    d_route(PH, ldsf, gridDim.x);
    xcd_barrier(bar);
    d_seglist(PH, seg_lds);
    conv_experts(PH, 128, GU1B_FIRST, true, false, blockIdx.x, gridDim.x, ldsf, 0, 1 << 30, false, false, true);
    ph_sh2(PH, lds);
    xcd_barrier(bar);
    (void)ph_moe1(PH, lds, 0, 256);
    xcd_barrier(bar);
    ph_moe2(PH, lds, 0, 256);
    xcd_barrier(bar);
    d_final(PH, false, ldsf);
}

extern "C" void kernel_launch(void* const* d_in, const int* in_sizes, int n_in, void* d_out, int out_size, void* d_ws, size_t ws_size, hipStream_t stream) {
    static int grid = 0;
    if (grid == 0) {
        if (n_in != 31 || ws_size < WS_END || out_size != T * DM) { fprintf(stderr, "kernel_launch: unexpected shapes (n_in %d ws %zu out %d)\n", n_in, ws_size, out_size); grid = -1; return; }
        int dev = 0, cus = 0, per_cu = 0;
        if (hipGetDevice(&dev) != hipSuccess || hipDeviceGetAttribute(&cus, hipDeviceAttributeMultiprocessorCount, dev) != hipSuccess) { grid = -1; return; }
        if (hipFuncSetAttribute((const void*)mega, hipFuncAttributeMaxDynamicSharedMemorySize, LDS_TOTAL) != hipSuccess) { fprintf(stderr, "kernel_launch: hipFuncSetAttribute failed\n"); grid = -1; return; }
        if (hipOccupancyMaxActiveBlocksPerMultiprocessor(&per_cu, (const void*)mega, NT, LDS_TOTAL) != hipSuccess || per_cu < 1) { fprintf(stderr, "kernel_launch: occupancy query says %d blocks/CU\n", per_cu); (void)hipGetLastError(); grid = -1; return; }
        if (cus != 256) { fprintf(stderr, "kernel_launch: built for a 256-CU device (got %d); nothing launched\n", cus); grid = -1; return; }
        grid = cus;
    }
    if (grid < 0) return;
    (void)hipMemsetAsync((char*)d_ws + WS_CTL, 0, 65536, stream);
    P p{};
    for (int i = 0; i < 31; ++i) p.in[i] = (const float*)d_in[i];
    p.out = (float*)d_out; p.ws = (unsigned char*)d_ws;
    hipLaunchKernelGGL(mega, dim3(grid), dim3(NT), LDS_TOTAL, stream, p);
}
```

```cpp
#include <hip/hip_runtime.h>
#include <cstdio>
#include <cstdint>
#include <cmath>

typedef unsigned short bf16_t;

constexpr int BATCH = 16, SEQ = 2048, DM = 1024, T = BATCH * SEQ;
constexpr int D_S5 = 512, S5_G = 32, S5_C = 16, S5_N = 64;
constexpr int GLA_H = 4, GLA_DK = 64, GLA_DV = 128, GLA_QK = 256, D_GLA = 512;
constexpr int D_IN = 2064;
constexpr int NE = 256, TOPK = 8, DE = 256;
constexpr int NPAIR = T * TOPK;
constexpr float EPS = 1e-6f, ROUTED_SCALE = 2.5f;
constexpr int NT = 512;

constexpr size_t MiB = (size_t)1 << 20;
constexpr size_t WS_CTL = 0;
constexpr size_t CTL_COUNTS = 32768;
constexpr int CNT_STRIDE = 32;
constexpr size_t CTL_BAR = 16384;
constexpr size_t WS_MOD = 1 * MiB;
constexpr size_t WS_WCOMB = 2 * MiB;
constexpr size_t WS_S5P = 3 * MiB;
constexpr size_t WS_PAIRI = 4 * MiB;
constexpr size_t WS_PAIRG = 5 * MiB;
constexpr size_t WS_LIST = 6 * MiB;
constexpr size_t LIST_ENTRIES = (size_t)NPAIR + 256 * 256;
constexpr size_t WS_SEG = 7 * MiB + 512 * 1024;
constexpr size_t WS_WINT = 8 * MiB, WS_WGLUT = 13 * MiB, WS_WOUTT = 14 * MiB, WS_WRS = 16 * MiB, WS_WSDT = 18 * MiB;
constexpr size_t WS_RSS1 = 19 * MiB, WS_RSS2 = 20 * MiB;
constexpr size_t WS_WGU = 24 * MiB, WS_WD = 152 * MiB, WS_H2 = 216 * MiB, WS_YSH = 280 * MiB, WS_Y = 344 * MiB, WS_H = 856 * MiB  , WS_HSH = 1006 * MiB;
constexpr size_t WS_HBUF = 344 * MiB, WS_PROJ = 408 * MiB, WS_LOGA = 536 * MiB, WS_GBUF = 568 * MiB, WS_MIX = 600 * MiB, WS_LOGITS = 664 * MiB;
constexpr size_t WS_WD1 = 760 * MiB;
constexpr size_t WS_WGU1B = 824 * MiB;
constexpr size_t WS_WGU1A = 600 * MiB;
constexpr int GU1B_FIRST = 96;
constexpr size_t WS_X1B = 696 * MiB;
constexpr size_t WS_END = 1024 * MiB;

struct P {
    const float* in[31];
    float* out;
    unsigned char* ws;
};
typedef const __attribute__((address_space(4))) P CP;
enum { I_X = 0, I_C, I_WADA, I_BADA, I_GMIX, I_WIN, I_LRE, I_LIM, I_LOGDT, I_BRE, I_BIM, I_CRE, I_CIM, I_S5D, I_WGLU, I_BGLU, I_S5NG,
       I_WG2, I_BG2, I_GLANG, I_WOUT, I_GMOE, I_WR, I_RB, I_EWG, I_EWU, I_EWD, I_SWG, I_SWU, I_SWD, I_GFIN };

__device__ __forceinline__ bf16_t f2bf(float f) { __bf16 b = (__bf16)f; return __builtin_bit_cast(unsigned short, b); }
__device__ __forceinline__ float bf2f(bf16_t h) { return __uint_as_float(((unsigned)h) << 16); }
__device__ __forceinline__ float sigmoidf_(float x) { return 1.f / (1.f + expf(-x)); }
__device__ __forceinline__ float siluf_(float x) { return x * sigmoidf_(x); }
__device__ __forceinline__ float gelu_tanh(float x) { const float k = 0.7978845608028654f; return 0.5f * x * (1.f + tanhf(k * (x + 0.044715f * x * x * x))); }
__device__ __forceinline__ float wave_sum(float v) {
#pragma unroll
    for (int o = 1; o < 64; o <<= 1) v += __shfl_xor(v, o);
    return v;
}

namespace g8 {
#define G8_LAS __attribute__((address_space(3)))
typedef short bf16x8 __attribute__((ext_vector_type(8)));
typedef float f32x4 __attribute__((ext_vector_type(4)));
typedef unsigned u32x4 __attribute__((ext_vector_type(4)));
typedef unsigned u32x2 __attribute__((ext_vector_type(2)));
constexpr int BM = 256, BK = 64, HALF = 128, HTB = HALF * BK * 2, STAGE_BYTES = 8 * HTB, NXCD = 8, WGM = 8;

__host__ __device__ __forceinline__ int lds_byte(int r, int c) { const int st = (r >> 4) * 2 + (c >> 5), rr = r & 15, cc = c & 31, ob = rr * 64 + cc * 2; return st * 1024 + (ob ^ (((ob >> 9) & 1) << 5)); }
__host__ __device__ __forceinline__ void stage_rc(int b, int& R, int& C) { const int st = b / 1024, sb = b % 1024, swz = sb ^ (((sb >> 9) & 1) << 5); R = (st >> 1) * 16 + swz / 64; C = (st & 1) * 32 + (swz % 64) / 2; }
__host__ __device__ __forceinline__ int perm32(int rho) { const int n = rho >> 4, i = rho & 15; return 8 * (i >> 2) + 4 * n + (i & 3); }

struct Unit { int pm, pn, e, cnt, seg; };

__device__ __forceinline__ unsigned cvt_pk_bf16(float lo, float hi) { unsigned r; asm volatile("v_cvt_pk_bf16_f32 %0, %1, %2" : "=v"(r) : "v"(lo), "v"(hi)); return r; }

struct DenseOrder {
    const char* A; const char* Bt; int K; int nM, nN, nwg, G, c;
    __device__ void init(const void* A_, const void* Bt_, int M, int N, int K_, int G_, int c_) { A = (const char*)A_; Bt = (const char*)Bt_; K = K_; nM = M / BM; nN = N / BM; nwg = nM * nN; G = G_; c = c_; }
    __device__ bool next(int i, Unit& u) const {
        const long L = (long)i * G + c; if (L >= nwg) return false;
        int wgid = (int)L; { const int q = nwg / NXCD, r = nwg % NXCD, xcd = wgid % NXCD, off = wgid / NXCD; wgid = (xcd < r ? xcd * (q + 1) : r * (q + 1) + (xcd - r) * q) + off; }
        const int nig = WGM * nN, gid = wgid / nig, fm = gid * WGM, gsz = (nM - fm) < WGM ? (nM - fm) : WGM;
        u.pm = fm + ((wgid % nig) % gsz); u.pn = (wgid % nig) / gsz; u.e = 0; u.cnt = BM; u.seg = 0; return true;
    }
    __device__ __forceinline__ const char* a_ptr(const Unit& u) const { return A + (size_t)u.pm * BM * K * 2; }
    __device__ __forceinline__ const char* b_ptr(const Unit& u) const { return Bt + (size_t)u.pn * BM * K * 2; }
    __device__ __forceinline__ const int* rows(const Unit&) const { return nullptr; }
};

template <class Epi, class Sched, bool GATHER, bool ALIGN_EPI, bool TILEDB = false>
__device__ __forceinline__ void gemm_phase(G8_LAS unsigned char* lds, G8_LAS unsigned* gslot, const int K, const Sched& S, Epi& E) {
    int tid_ = threadIdx.x; asm volatile("" : "+v"(tid_));
    const int tid = tid_, wid = __builtin_amdgcn_readfirstlane(tid >> 6), lane = tid & 63, wr = wid >> 2, wc = wid & 3, fr = lane & 15, fq = lane >> 4;
    const int nt = K / BK;
    unsigned voffA[2], voffB[2]; int R0 = 0, C0 = 0;
#pragma unroll
    for (int i = 0; i < 2; ++i) { int R, C; stage_rc(tid * 16 + i * 8192, R, C); const int Rb = Epi::PERM ? ((R & ~31) + perm32(R & 31)) : R;
        voffA[i] = (unsigned)(R * K + C) * 2u; voffB[i] = TILEDB ? (unsigned)(Rb * BK + C) * 2u : (unsigned)(Rb * K + C) * 2u; if (i == 0) { R0 = R; C0 = C; } }
    unsigned aoff[4] = {0u, 0u, 0u, 0u};
    const size_t kstep = (size_t)(BK * 2);
    const size_t hstep = (size_t)HALF * K * 2;
    const size_t kstepB = TILEDB ? (size_t)(BM * BK * 2) : kstep, hstepB = TILEDB ? (size_t)(HALF * BK * 2) : hstep;
    const unsigned ldsw = (unsigned)wid * 1024u;
    const int aoffl = lds_byte(wr * 64 + fr, fq * 8), boffl = lds_byte(wc * 32 + fr, fq * 8);
#define G8_SA(b, h) (((b) * 2 + (h)) * HTB)
#define G8_SB(b, h) ((4 + (b) * 2 + (h)) * HTB)
#define G8_GLDS(gp, lp) __builtin_amdgcn_global_load_lds((const unsigned*)(gp), (G8_LAS unsigned*)(lp), 16, 0, 0)
#define G8_STAGE_B(bufoff, gbase) do { _Pragma("unroll") for (int _i = 0; _i < 2; ++_i) G8_GLDS((const char*)(gbase) + voffB[_i], lds + (bufoff) + ldsw + _i * 8192); } while (0)
#define G8_STAGE_A(bufoff, gbase, h) do { _Pragma("unroll") for (int _i = 0; _i < 2; ++_i) { \
        if constexpr (GATHER) G8_GLDS((const char*)(gbase) + aoff[(h) * 2 + _i], lds + (bufoff) + ldsw + _i * 8192); \
        else G8_GLDS((const char*)(gbase) + (h) * hstep + voffA[_i], lds + (bufoff) + ldsw + _i * 8192); } } while (0)
#define G8_LDA(dst, b, h) do { _Pragma("unroll") for (int m = 0; m < 4; ++m) _Pragma("unroll") for (int k = 0; k < 2; ++k) dst[m][k] = *(const G8_LAS bf16x8*)(lds + G8_SA(b, h) + aoffl + m * 2048 + k * 1024); } while (0)
#define G8_LDB(dst, b, h) do { _Pragma("unroll") for (int n = 0; n < 2; ++n) _Pragma("unroll") for (int k = 0; k < 2; ++k) dst[n][k] = *(const G8_LAS bf16x8*)(lds + G8_SB(b, h) + boffl + n * 2048 + k * 1024); } while (0)
#define G8_MMA(ai, bj, At, Bt) do { __builtin_amdgcn_s_setprio(1); _Pragma("unroll") for (int m = 0; m < 4; ++m) _Pragma("unroll") for (int n = 0; n < 2; ++n) _Pragma("unroll") for (int k = 0; k < 2; ++k) \
        acc[ai][bj][m][n] = __builtin_amdgcn_mfma_f32_16x16x32_bf16(Bt[n][k], At[m][k], acc[ai][bj][m][n], 0, 0, 0); __builtin_amdgcn_s_setprio(0); } while (0)
#define G8_WAIT_V(n) asm volatile("s_waitcnt vmcnt(" #n ")" ::: "memory")
#define G8_WAIT_L(n) asm volatile("s_waitcnt lgkmcnt(" #n ")" ::: "memory")
#define G8_BAR __builtin_amdgcn_s_barrier()
#define G8_SCHED __builtin_amdgcn_sched_barrier(0)
#define G8_LOAD_AOFF(rowsp, dstarr) do { _Pragma("unroll") for (int _j = 0; _j < 4; ++_j) { const int _q = (rowsp)[(_j >> 1) * 128 + (_j & 1) * 64 + R0]; const unsigned _tok = _q < 0 ? 0u : (unsigned)(_q >> 3); dstarr[_j] = _tok * (unsigned)(K * 2) + (unsigned)(C0 * 2); } } while (0)
    Unit cur, nxt; int ui = 0;
    if (!S.next(0, cur)) return;
    f32x4 acc[2][2][4][2];
#pragma unroll
    for (int a = 0; a < 2; ++a)
#pragma unroll
        for (int b = 0; b < 2; ++b)
#pragma unroll
            for (int m = 0; m < 4; ++m)
#pragma unroll
                for (int n = 0; n < 2; ++n) acc[a][b][m][n] = (f32x4){0.f, 0.f, 0.f, 0.f};
    bf16x8 At[4][2], B0[2][2], B1[2][2];
    const char* cA = S.a_ptr(cur); const char* cB = S.b_ptr(cur);
    if constexpr (GATHER) { const int* rp = S.rows(cur); G8_LOAD_AOFF(rp, aoff); }
    G8_STAGE_B(G8_SB(0, 0), cB); G8_STAGE_B(G8_SB(0, 1), cB + hstepB); G8_STAGE_A(G8_SA(0, 0), cA, 0); G8_STAGE_A(G8_SA(0, 1), cA, 1);
    if (wr == 1) G8_BAR;
    G8_WAIT_V(2); G8_BAR;
    G8_STAGE_B(G8_SB(1, 0), cB + kstepB); G8_STAGE_A(G8_SA(1, 0), cA + kstep, 0); G8_STAGE_B(G8_SB(1, 1), cB + hstepB + kstepB);
    G8_WAIT_V(6); G8_BAR;
    for (;;) {
        const bool has_next = S.next(ui + 1, nxt);
        const char* nA = has_next ? S.a_ptr(nxt) : cA; const char* nB = has_next ? S.b_ptr(nxt) : cB;
        if constexpr (GATHER) { if (has_next) { const int* rp = S.rows(nxt); unsigned na[4]; G8_LOAD_AOFF(rp, na);
#pragma unroll
                for (int j = 0; j < 4; ++j) gslot[tid * 4 + j] = na[j]; } }
        if constexpr (Epi::PREFETCH) E.pre(cur, wr, fr);
#pragma nounroll
        for (int t = 0; t < nt; t += 2) {
            const bool last = (t == nt - 2);
            const char* a1 = cA + (size_t)(t + 1) * kstep;
            const char* a2 = last ? nA : cA + (size_t)(t + 2) * kstep; const char* b2 = last ? nB : cB + (size_t)(t + 2) * kstepB;
            const char* a3 = a2 + kstep; const char* b3 = b2 + kstepB;
            if constexpr (Epi::MIDK > 0) { if (t == Epi::MIDK) E.mid(acc, cur, wr, wc, fr, fq); }
            G8_LDB(B0, 0, 0); G8_LDB(B1, 0, 1); G8_SCHED; G8_LDA(At, 0, 0); G8_STAGE_A(G8_SA(1, 1), a1, 1);
            if constexpr (GATHER) { if (last && has_next) {
#pragma unroll
                for (int j = 0; j < 4; ++j) aoff[j] = gslot[tid * 4 + j]; } }
            G8_WAIT_V(8); G8_WAIT_L(0); G8_BAR; G8_MMA(0, 0, At, B0); G8_MMA(0, 1, At, B1); G8_BAR; G8_SCHED;
            G8_LDA(At, 0, 1); G8_STAGE_B(G8_SB(0, 0), b2); G8_STAGE_B(G8_SB(0, 1), b2 + hstepB); G8_STAGE_A(G8_SA(0, 0), a2, 0);
            G8_WAIT_V(8); G8_WAIT_L(0); G8_BAR; G8_MMA(1, 0, At, B0); G8_MMA(1, 1, At, B1); G8_BAR; G8_SCHED;
            G8_LDB(B0, 1, 0); G8_LDB(B1, 1, 1); G8_SCHED; G8_LDA(At, 1, 0); G8_STAGE_A(G8_SA(0, 1), a2, 1);
            G8_WAIT_V(8); G8_WAIT_L(0); G8_BAR; G8_MMA(0, 0, At, B0); G8_MMA(0, 1, At, B1); G8_BAR; G8_SCHED;
            G8_LDA(At, 1, 1); G8_STAGE_B(G8_SB(1, 0), b3); G8_STAGE_B(G8_SB(1, 1), b3 + hstepB); G8_STAGE_A(G8_SA(1, 0), a3, 0);
            G8_WAIT_V(8); G8_WAIT_L(0); G8_BAR; G8_MMA(1, 0, At, B0); G8_MMA(1, 1, At, B1); G8_BAR; G8_SCHED;
        }
        if (ALIGN_EPI) { if (wr == 0) G8_BAR; }
        E(acc, cur, wr, wc, fr, fq);
        if (!has_next) break;
#pragma unroll
        for (int a = 0; a < 2; ++a)
#pragma unroll
            for (int b = 0; b < 2; ++b)
#pragma unroll
                for (int m = 0; m < 4; ++m)
#pragma unroll
                    for (int n = 0; n < 2; ++n) acc[a][b][m][n] = (f32x4){0.f, 0.f, 0.f, 0.f};
        cur = nxt; cA = nA; cB = nB; ++ui;
        if (ALIGN_EPI) { if (wr == 1) G8_BAR; }
    }
    G8_WAIT_V(0);
    if (!ALIGN_EPI) { if (wr == 0) G8_BAR; }
    G8_BAR;
#undef G8_SA
#undef G8_SB
#undef G8_GLDS
#undef G8_STAGE_A
#undef G8_STAGE_B
#undef G8_LDA
#undef G8_LDB
#undef G8_MMA
#undef G8_WAIT_V
#undef G8_WAIT_L
#undef G8_BAR
#undef G8_SCHED
#undef G8_LOAD_AOFF
}
}
namespace g8 {
__device__ __forceinline__ float logsig16(float x) { return (fminf(x, 0.f) - log1pf(__expf(-fabsf(x)))) * (1.f / 16.f); }
__device__ __forceinline__ float fsigmoid(float x) { return __builtin_amdgcn_rcpf(1.f + __expf(-x)); }

struct EpiInproj {
    static constexpr bool PERM = true; static constexpr int MIDK = 0; static constexpr bool PREFETCH = false;
    bf16_t* proj; float* loga; const float* bg2;
    __device__ __forceinline__ void operator()(const f32x4 (&acc)[2][2][4][2], const Unit& u, int wr, int wc, int fr, int fq) const {
        const int row0 = u.pm * BM + wr * 64 + fr;
        if (u.pn < 8) {
            const int col0 = u.pn * BM + wc * 32 + 8 * fq;
#pragma unroll
            for (int ai = 0; ai < 2; ++ai)
#pragma unroll
                for (int m = 0; m < 4; ++m) { bf16_t* rowp = proj + (size_t)(row0 + ai * HALF + m * 16) * 2048 + col0;
#pragma unroll
                    for (int bj = 0; bj < 2; ++bj) { const f32x4 v0 = acc[ai][bj][m][0], v1 = acc[ai][bj][m][1]; u32x4 w;
                        w.x = cvt_pk_bf16(v0[0], v0[1]); w.y = cvt_pk_bf16(v0[2], v0[3]); w.z = cvt_pk_bf16(v1[0], v1[1]); w.w = cvt_pk_bf16(v1[2], v1[3]);
                        *(u32x4*)(rowp + bj * HALF) = w; } }
        } else {
            const int col0 = wc * 32 + 8 * fq;
            f32x4 bv[2][2];
#pragma unroll
            for (int bj = 0; bj < 2; ++bj)
#pragma unroll
                for (int n = 0; n < 2; ++n) bv[bj][n] = *(const f32x4*)(bg2 + col0 + bj * HALF + 4 * n);
#pragma unroll
            for (int ai = 0; ai < 2; ++ai)
#pragma unroll
                for (int m = 0; m < 4; ++m) { float* rowp = loga + (size_t)(row0 + ai * HALF + m * 16) * 256 + col0;
#pragma unroll
                    for (int bj = 0; bj < 2; ++bj)
#pragma unroll
                        for (int n = 0; n < 2; ++n) { const f32x4 x = acc[ai][bj][m][n] + bv[bj][n]; f32x4 o;
                            o[0] = logsig16(x[0]); o[1] = logsig16(x[1]); o[2] = logsig16(x[2]); o[3] = logsig16(x[3]);
                            *(f32x4*)(rowp + bj * HALF + 4 * n) = o; } }
        }
    }
};

struct EpiGlu {
    static constexpr bool PERM = true; static constexpr int MIDK = 0; static constexpr bool PREFETCH = false;
    const bf16_t* gb; bf16_t* mix; const float* bgl; float* rowss;
    __device__ __forceinline__ void operator()(const f32x4 (&acc)[2][2][4][2], const Unit& u, int wr, int wc, int fr, int fq) const {
        const int row0 = u.pm * BM + wr * 64 + fr, col0 = u.pn * BM + wc * 32 + 8 * fq;
        f32x4 bv[2][2];
#pragma unroll
        for (int bj = 0; bj < 2; ++bj)
#pragma unroll
            for (int n = 0; n < 2; ++n) bv[bj][n] = *(const f32x4*)(bgl + col0 + bj * HALF + 4 * n);
#pragma unroll
        for (int ai = 0; ai < 2; ++ai)
#pragma unroll
            for (int m = 0; m < 4; ++m) { const int row = row0 + ai * HALF + m * 16; float ss = 0.f;
#pragma unroll
                for (int bj = 0; bj < 2; ++bj) { const u32x4 gw = *(const u32x4*)(gb + (size_t)row * 512 + col0 + bj * HALF);
                    float g[8]; g[0] = __uint_as_float(gw.x << 16); g[1] = __uint_as_float(gw.x & 0xffff0000u); g[2] = __uint_as_float(gw.y << 16); g[3] = __uint_as_float(gw.y & 0xffff0000u);
                    g[4] = __uint_as_float(gw.z << 16); g[5] = __uint_as_float(gw.z & 0xffff0000u); g[6] = __uint_as_float(gw.w << 16); g[7] = __uint_as_float(gw.w & 0xffff0000u);
                    float o[8];
#pragma unroll
                    for (int n = 0; n < 2; ++n)
#pragma unroll
                        for (int j = 0; j < 4; ++j) { const float v = g[n * 4 + j] * fsigmoid(acc[ai][bj][m][n][j] + bv[bj][n][j]); o[n * 4 + j] = v; ss += v * v; }
                    u32x4 w; w.x = cvt_pk_bf16(o[0], o[1]); w.y = cvt_pk_bf16(o[2], o[3]); w.z = cvt_pk_bf16(o[4], o[5]); w.w = cvt_pk_bf16(o[6], o[7]);
                    *(u32x4*)(mix + (size_t)row * DM + col0 + bj * HALF) = w; }
                ss += __shfl_xor(ss, 16); ss += __shfl_xor(ss, 32);
                if (fq == 0) rowss[(size_t)u.pn * (T * 4) + (size_t)row * 4 + wc] = ss; }
    }
};

struct EpiWout {
    static constexpr bool PERM = true; static constexpr int MIDK = 8; static constexpr bool PREFETCH = false;
    const float* x; bf16_t* x1b; const float* mod; const float* rowss1; float* rowss2;
    __device__ __forceinline__ void mid(f32x4 (&acc)[2][2][4][2], const Unit& u, int wr, int wc, int fr, int fq) const {
        const int row0 = u.pm * BM + wr * 64 + fr;
        float sm[2];
#pragma unroll
        for (int i = 0; i < 2; ++i) { const int idx = 2 * fq + i; const float* rp = rowss1 + (size_t)(row0 + (idx >> 2) * HALF + (idx & 3) * 16) * 4;
            const f32x4 q0 = *(const f32x4*)rp, q1 = *(const f32x4*)(rp + (size_t)T * 4);
            float sq = q0[0]; sq += q0[1]; sq += q0[2]; sq += q0[3]; sq += q1[0]; sq += q1[1]; sq += q1[2]; sq += q1[3];
            sm[i] = rsqrtf(sq * (1.f / 512.f) + EPS); asm volatile("" ::: "memory"); }
#pragma unroll
        for (int idx = 0; idx < 8; ++idx) { const float s = __shfl(sm[idx & 1], fr + 16 * (idx >> 1));
#pragma unroll
            for (int bj = 0; bj < 2; ++bj)
#pragma unroll
                for (int n = 0; n < 2; ++n) acc[idx >> 2][bj][idx & 3][n] *= s; }
    }
    __device__ __forceinline__ void operator()(const f32x4 (&acc)[2][2][4][2], const Unit& u, int wr, int wc, int fr, int fq) const {
        const int row0 = u.pm * BM + wr * 64 + fr, col0 = u.pn * BM + wc * 32 + 8 * fq;
        const int b = (u.pm * BM) / SEQ;
        f32x4 gt[2][2];
#pragma unroll
        for (int bj = 0; bj < 2; ++bj)
#pragma unroll
            for (int n = 0; n < 2; ++n) gt[bj][n] = *(const f32x4*)(mod + b * 6 * DM + 2 * DM + col0 + bj * HALF + 4 * n);
#pragma unroll
        for (int ai = 0; ai < 2; ++ai)
#pragma unroll
            for (int m = 0; m < 4; ++m) { const int row = row0 + ai * HALF + m * 16; const size_t off = (size_t)row * DM + col0; float ss = 0.f;
#pragma unroll
                for (int bj = 0; bj < 2; ++bj) { const f32x4 x0 = *(const f32x4*)(x + off + bj * HALF), x1v = *(const f32x4*)(x + off + bj * HALF + 4);
                    const f32x4 o0 = x0 + gt[bj][0] * acc[ai][bj][m][0], o1 = x1v + gt[bj][1] * acc[ai][bj][m][1];
                    u32x4 w; w.x = cvt_pk_bf16(o0[0], o0[1]); w.y = cvt_pk_bf16(o0[2], o0[3]); w.z = cvt_pk_bf16(o1[0], o1[1]); w.w = cvt_pk_bf16(o1[2], o1[3]);
                    *(u32x4*)(x1b + off + bj * HALF) = w;
                    ss += (o0[0] * o0[0] + o0[1] * o0[1]) + (o0[2] * o0[2] + o0[3] * o0[3]) + (o1[0] * o1[0] + o1[1] * o1[1]) + (o1[2] * o1[2] + o1[3] * o1[3]); }
                ss += __shfl_xor(ss, 16); ss += __shfl_xor(ss, 32);
                if (fq == 0) rowss2[(size_t)u.pn * (T * 4) + (size_t)row * 4 + wc] = ss; }
    }
};

struct EpiRS {
    static constexpr bool PERM = true; static constexpr int MIDK = 0; static constexpr bool PREFETCH = false;
    float* logits; bf16_t* Hs;
    __device__ __forceinline__ void operator()(const f32x4 (&acc)[2][2][4][2], const Unit& u, int wr, int wc, int fr, int fq) const {
        const int row0 = u.pm * BM + wr * 64 + fr, c0 = wc * 32 + 8 * fq;
        if (u.pn == 0) {
#pragma unroll
            for (int ai = 0; ai < 2; ++ai)
#pragma unroll
                for (int m = 0; m < 4; ++m) { float* rowp = logits + (size_t)(row0 + ai * HALF + m * 16) * 256 + c0;
#pragma unroll
                    for (int bj = 0; bj < 2; ++bj)
#pragma unroll
                        for (int n = 0; n < 2; ++n) *(f32x4*)(rowp + bj * HALF + 4 * n) = acc[ai][bj][m][n]; }
        } else {
            const int hc = (u.pn - 1) * 128 + c0;
#pragma unroll
            for (int ai = 0; ai < 2; ++ai)
#pragma unroll
                for (int m = 0; m < 4; ++m) { float o[8];
#pragma unroll
                    for (int n = 0; n < 2; ++n)
#pragma unroll
                        for (int j = 0; j < 4; ++j) { const float g = acc[ai][0][m][n][j], up = acc[ai][1][m][n][j]; o[n * 4 + j] = g * fsigmoid(g) * up; }
                    u32x4 w; w.x = cvt_pk_bf16(o[0], o[1]); w.y = cvt_pk_bf16(o[2], o[3]); w.z = cvt_pk_bf16(o[4], o[5]); w.w = cvt_pk_bf16(o[6], o[7]);
                    *(u32x4*)(Hs + (size_t)(row0 + ai * HALF + m * 16) * DE + hc) = w; }
        }
    }
};

struct EpiPlain {
    static constexpr bool PERM = true; static constexpr int MIDK = 0; static constexpr bool PREFETCH = false;
    bf16_t* O; int ldc;
    __device__ __forceinline__ void operator()(const f32x4 (&acc)[2][2][4][2], const Unit& u, int wr, int wc, int fr, int fq) const {
        const int row0 = u.pm * BM + wr * 64 + fr, col0 = u.pn * BM + wc * 32 + 8 * fq;
#pragma unroll
        for (int ai = 0; ai < 2; ++ai)
#pragma unroll
            for (int m = 0; m < 4; ++m) { bf16_t* rowp = O + (size_t)(row0 + ai * HALF + m * 16) * ldc + col0;
#pragma unroll
                for (int bj = 0; bj < 2; ++bj) { const f32x4 v0 = acc[ai][bj][m][0], v1 = acc[ai][bj][m][1]; u32x4 w;
                    w.x = cvt_pk_bf16(v0[0], v0[1]); w.y = cvt_pk_bf16(v0[2], v0[3]); w.z = cvt_pk_bf16(v1[0], v1[1]); w.w = cvt_pk_bf16(v1[2], v1[3]);
                    *(u32x4*)(rowp + bj * HALF) = w; } }
    }
};
struct EpiFp8 {
    static constexpr bool PERM = true; static constexpr int MIDK = 0; static constexpr bool PREFETCH = false;
    unsigned char* O; int ldc;
    __device__ __forceinline__ void operator()(const f32x4 (&acc)[2][2][4][2], const Unit& u, int wr, int wc, int fr, int fq) const {
        const int row0 = u.pm * BM + wr * 64 + fr, col0 = u.pn * BM + wc * 32 + ((fq & 1) ? HALF + 8 * (fq - 1) : 8 * fq);
#pragma unroll
        for (int ai = 0; ai < 2; ++ai)
#pragma unroll
            for (int m = 0; m < 4; ++m) { u32x2 w0, w1; w0.x = w0.y = w1.x = w1.y = 0u;
#if defined(__HIP_DEVICE_COMPILE__)
                { const f32x4 v0 = acc[ai][0][m][0] * 16.f, v1 = acc[ai][0][m][1] * 16.f;
                  w0.x = __builtin_amdgcn_cvt_pk_fp8_f32(v0[0], v0[1], w0.x, false); w0.x = __builtin_amdgcn_cvt_pk_fp8_f32(v0[2], v0[3], w0.x, true);
                  w0.y = __builtin_amdgcn_cvt_pk_fp8_f32(v1[0], v1[1], w0.y, false); w0.y = __builtin_amdgcn_cvt_pk_fp8_f32(v1[2], v1[3], w0.y, true); }
                { const f32x4 v0 = acc[ai][1][m][0] * 16.f, v1 = acc[ai][1][m][1] * 16.f;
                  w1.x = __builtin_amdgcn_cvt_pk_fp8_f32(v0[0], v0[1], w1.x, false); w1.x = __builtin_amdgcn_cvt_pk_fp8_f32(v0[2], v0[3], w1.x, true);
                  w1.y = __builtin_amdgcn_cvt_pk_fp8_f32(v1[0], v1[1], w1.y, false); w1.y = __builtin_amdgcn_cvt_pk_fp8_f32(v1[2], v1[3], w1.y, true); }
                { const bool od = fq & 1;
                  const unsigned rx = (unsigned)__shfl_xor((int)(od ? w0.x : w1.x), 16), ry = (unsigned)__shfl_xor((int)(od ? w0.y : w1.y), 16);
                  w0.x = od ? rx : w0.x; w1.x = od ? w1.x : rx; w0.y = od ? ry : w0.y; w1.y = od ? w1.y : ry; }
#endif
                u32x4 o; o.x = w0.x; o.y = w0.y; o.z = w1.x; o.w = w1.y; *(u32x4*)(O + (size_t)(row0 + ai * HALF + m * 16) * ldc + col0) = o; }
    }
};
}
constexpr int LDS_RING = 131072, LDS_GSLOT = 131072, LDS_TOTAL = 147456;
struct TrItem { const float* src; int ld; bf16_t* dst; int Kd; int gs; const float* ksc; };
__device__ __forceinline__ void tr_load(const TrItem& it, float4 (&v)[8]) {
    const int tid = threadIdx.x, n4 = tid & 63, kq = tid >> 6;
#pragma unroll
    for (int i = 0; i < 8; ++i) { typedef float f32x4v __attribute__((ext_vector_type(4))); const f32x4v t = *(const f32x4v*)(it.src + (size_t)(i * 8 + kq) * it.ld + n4 * 4); v[i] = make_float4(t[0], t[1], t[2], t[3]); }
}
__device__ __forceinline__ void tr_to_lds(const TrItem& it, const float4 (&v)[8], float* lds) {
    const int tid = threadIdx.x, n4 = tid & 63, kq = tid >> 6;
#pragma unroll
    for (int i = 0; i < 8; ++i) { const int k = i * 8 + kq; const float s = it.ksc ? it.ksc[k] : 1.f; const int col = (n4 * 4 + 4 * (k >> 3)) & 255;
        float4 w = v[i]; w.x *= s; w.y *= s; w.z *= s; w.w *= s; *(float4*)(lds + k * 260 + col) = w; }
}
__device__ __forceinline__ void tr_store(const TrItem& it, const float* lds) {
    const int tid = threadIdx.x;
#pragma unroll
    for (int i = 0; i < 4; ++i) { const int c = tid + i * NT, n = c >> 3, k8 = c & 7, col = (n + 4 * k8) & 255;
        float f[8];
#pragma unroll
        for (int j = 0; j < 8; ++j) f[j] = lds[(k8 * 8 + j) * 260 + col];
        uint4 o; o.x = (unsigned)f2bf(f[0]) | ((unsigned)f2bf(f[1]) << 16); o.y = (unsigned)f2bf(f[2]) | ((unsigned)f2bf(f[3]) << 16);
        o.z = (unsigned)f2bf(f[4]) | ((unsigned)f2bf(f[5]) << 16); o.w = (unsigned)f2bf(f[6]) | ((unsigned)f2bf(f[7]) << 16);
        const int row = (n >> 7) * it.gs + (n & 127);
        *(uint4*)(it.dst + (size_t)row * it.Kd + k8 * 8) = o; }
}
template <class Get>
__device__ __forceinline__ void tr_run(int first, int step, int count, Get get, float* lds) {
    if (first >= count) return;
    const int nmine = (count - first + step - 1) / step;
    auto at = [&](int j) { return get(first + (j < nmine ? j : nmine - 1) * step); };
    TrItem A = at(0), B = at(1); float4 vA[8], vB[8];
    tr_load(A, vA); tr_load(B, vB);
#pragma nounroll
    for (int j = 0; j < nmine; j += 2) {
        tr_to_lds(A, vA, lds);
        __syncthreads();
        const TrItem A2 = at(j + 2); tr_load(A2, vA);
        tr_store(A, lds);
        __syncthreads();
        tr_to_lds(B, vB, lds);
        __syncthreads();
        const TrItem B2 = at(j + 3); tr_load(B2, vB);
        tr_store(B, lds);
        __syncthreads();
        A = A2; B = B2;
    }
}
__device__ __forceinline__ void conv_small(CP& p, int bid, int nblk, float* lds) {
    bf16_t* WINT = (bf16_t*)(p.ws + WS_WINT); bf16_t* WGLUT = (bf16_t*)(p.ws + WS_WGLUT); bf16_t* WOUTT = (bf16_t*)(p.ws + WS_WOUTT);
    bf16_t* WRS = (bf16_t*)(p.ws + WS_WRS); bf16_t* WSDT = (bf16_t*)(p.ws + WS_WSDT);
    const float* win = p.in[I_WIN]; const float* wglu = p.in[I_WGLU]; const float* wout = p.in[I_WOUT]; const float* wr = p.in[I_WR];
    const float* swg = p.in[I_SWG]; const float* swu = p.in[I_SWU]; const float* swd = p.in[I_SWD]; const float* s5ng = p.in[I_S5NG];
    auto get = [&](int it) -> TrItem {
        int r = it;
        if (r < 96) { const int kb = r / 6, nb = r % 6; return TrItem{win + (size_t)kb * 64 * D_IN + nb * 256, D_IN, WINT + (size_t)nb * 256 * DM + kb * 64, DM, 128, nullptr}; } r -= 96;
        if (r < 32) { const int kb = r / 2, nb = r % 2; return TrItem{win + (size_t)kb * 64 * D_IN + 1552 + nb * 256, D_IN, WINT + (size_t)(1536 + nb * 256) * DM + kb * 64, DM, 128, nullptr}; } r -= 32;
        if (r < 16) { const int kb = r / 2, nb = r % 2; return TrItem{wglu + (size_t)kb * 64 * 512 + nb * 256, 512, WGLUT + (size_t)nb * 256 * 512 + kb * 64, 512, 128, nullptr}; } r -= 16;
        if (r < 64) { const int kb = r / 4, nb = r % 4; return TrItem{wout + (size_t)kb * 64 * DM + nb * 256, DM, WOUTT + (size_t)nb * 256 * DM + kb * 64, DM, 128, kb < 8 ? s5ng + kb * 64 : nullptr}; } r -= 64;
        if (r < 16) { return TrItem{wr + (size_t)r * 64 * 256, 256, WRS + r * 64, DM, 128, nullptr}; } r -= 16;
        if (r < 16) { return TrItem{swg + (size_t)r * 64 * 256, 256, WRS + (size_t)256 * DM + r * 64, DM, 256, nullptr}; } r -= 16;
        if (r < 16) { return TrItem{swu + (size_t)r * 64 * 256, 256, WRS + (size_t)384 * DM + r * 64, DM, 256, nullptr}; } r -= 16;
        { const int kb = r / 4, nb = r % 4; return TrItem{swd + (size_t)kb * 64 * DM + nb * 256, DM, WSDT + (size_t)nb * 256 * DE + kb * 64, DE, 128, nullptr}; }
    };
    tr_run(bid, nblk, 272, get, lds);
    const float* wg2 = p.in[I_WG2];
    for (int i = bid * NT + threadIdx.x; i < 256 * DM; i += nblk * NT) {
        const int n = i >> 10, k = i & 1023; float s = 0.f;
#pragma unroll
        for (int j = 0; j < 16; ++j) s += win[(size_t)k * D_IN + 1536 + j] * wg2[j * GLA_QK + n];
        WINT[(size_t)(2048 + n) * DM + k] = f2bf(s);
    }
}
__device__ __forceinline__ void ph_inproj(CP& p, G8_LAS unsigned char* lds) {
    g8::DenseOrder S; S.init(p.ws + WS_HBUF, p.ws + WS_WINT, T, 2304, DM, gridDim.x, blockIdx.x);
    g8::EpiInproj E{(bf16_t*)(p.ws + WS_PROJ), (float*)(p.ws + WS_LOGA), p.in[I_BG2]};
    g8::gemm_phase<g8::EpiInproj, g8::DenseOrder, false, true>(lds, (G8_LAS unsigned*)(lds + LDS_GSLOT), DM, S, E);
}
__device__ __forceinline__ void ph_glu(CP& p, G8_LAS unsigned char* lds) {
    g8::DenseOrder S; S.init(p.ws + WS_GBUF, p.ws + WS_WGLUT, T, 512, 512, gridDim.x, blockIdx.x);
    g8::EpiGlu E{(const bf16_t*)(p.ws + WS_GBUF), (bf16_t*)(p.ws + WS_MIX), p.in[I_BGLU], (float*)(p.ws + WS_RSS1)};
    g8::gemm_phase<g8::EpiGlu, g8::DenseOrder, false, true>(lds, (G8_LAS unsigned*)(lds + LDS_GSLOT), 512, S, E);
}
__device__ __forceinline__ void ph_wout(CP& p, G8_LAS unsigned char* lds) {
    g8::DenseOrder S; S.init(p.ws + WS_MIX, p.ws + WS_WOUTT, T, DM, DM, gridDim.x, blockIdx.x);
    g8::EpiWout E{p.in[I_X], (bf16_t*)(p.ws + WS_X1B), (const float*)(p.ws + WS_MOD), (const float*)(p.ws + WS_RSS1), (float*)(p.ws + WS_RSS2)};
    g8::gemm_phase<g8::EpiWout, g8::DenseOrder, false, true>(lds, (G8_LAS unsigned*)(lds + LDS_GSLOT), DM, S, E);
}
__device__ __forceinline__ void ph_rs(CP& p, G8_LAS unsigned char* lds, int G) {
    g8::DenseOrder S; S.init(p.ws + WS_H2, p.ws + WS_WRS, T, 768, DM, G, blockIdx.x);
    g8::EpiRS E{(float*)(p.ws + WS_LOGITS), (bf16_t*)(p.ws + WS_HSH)};
    g8::gemm_phase<g8::EpiRS, g8::DenseOrder, false, true>(lds, (G8_LAS unsigned*)(lds + LDS_GSLOT), DM, S, E);
}
__device__ __forceinline__ void ph_sh2(CP& p, G8_LAS unsigned char* lds) {
    g8::DenseOrder S; S.init(p.ws + WS_HSH, p.ws + WS_WSDT, T, DM, DE, gridDim.x, blockIdx.x);
    g8::EpiFp8 E{(unsigned char*)(p.ws + WS_YSH), DM};
    g8::gemm_phase<g8::EpiFp8, g8::DenseOrder, false, true>(lds, (G8_LAS unsigned*)(lds + LDS_GSLOT), DE, S, E);
}
constexpr int LDS_TP = LDS_GSLOT + 8192;
__device__ __forceinline__ void conv_experts(CP& p, int e0, int ne, bool doGU, bool doD, int bid, int nblk, float* lds, int ilo = 0, int ihi = 1 << 30, bool wd1 = false, bool gu1b = false, bool gu1a = false) {
    bf16_t* WGU = (bf16_t*)(p.ws + (gu1b ? WS_WGU1B : (gu1a ? WS_WGU1A : WS_WGU))); bf16_t* WD = (bf16_t*)(p.ws + (wd1 ? WS_WD1 : WS_WD));
    const float* ewg = p.in[I_EWG]; const float* ewu = p.in[I_EWU]; const float* ewd = p.in[I_EWD];
    const int per = (doGU ? 32 : 0) + (doD ? 16 : 0);
    auto get = [&](int it) -> TrItem {
        const int s = it / per; int r = it % per; const int e = e0 + s;
        if (doGU) {
            if (r < 16) return TrItem{ewg + (size_t)e * DM * DE + (size_t)r * 64 * DE, DE, WGU + ((size_t)(s * 2) * 16 + r) * 256 * 64, 64, 4096, nullptr}; r -= 16;
            if (r < 16) return TrItem{ewu + (size_t)e * DM * DE + (size_t)r * 64 * DE, DE, WGU + ((size_t)(s * 2) * 16 + r) * 256 * 64 + 128 * 64, 64, 4096, nullptr}; r -= 16;
        }
        const int kb = r / 4, nb = r % 4;
        return TrItem{ewd + (size_t)e * DE * DM + (size_t)kb * 64 * DM + nb * 256, DM, WD + ((size_t)(s * 4 + nb) * 4 + kb) * 256 * 64, 64, 128, nullptr};
    };
    const int total = ne * per; tr_run(ilo + bid, nblk, ihi < total ? ihi : total, get, lds);
}

namespace g8 {
struct MoeOrder {
    const char* A; const char* Bt; const char* Bt1; const char* Bt2; int es1, es2; const int* list; const int* seg; G8_LAS const int* tp; int K, nN, e0, G, c, nwg; size_t bstride  ; bool a_is_h; bool pn_major = false; bool tabled = false;
    __device__ void init(const void* A_, const void* Bt_, size_t bstride_, const int* counts, const int* seg_, const int* list_, G8_LAS int* tp_, int K_, int nN_, int e0_, int ne, int G_, int c_, bool a_is_h_) {
        A = (const char*)A_; Bt = (const char*)Bt_; Bt1 = Bt; Bt2 = Bt; es1 = es2 = 1 << 30; bstride = bstride_; list = list_; seg = seg_; K = K_; nN = nN_; e0 = e0_; G = G_; c = c_; a_is_h = a_is_h_;
        {
            const int tid = threadIdx.x, ln = tid & 63;
            const int v = tid < ne ? (counts[(e0_ + tid) * CNT_STRIDE] + 255) >> 8 : 0; int x = v;
#pragma unroll
            for (int o = 1; o < 64; o <<= 1) { const int y = __shfl_up(x, o); if (ln >= o) x += y; }
            if (ln == 63) tp_[516 + (tid >> 6)] = x;
            __syncthreads();
            int base = 0;
            for (int w = 0; w < (tid >> 6); ++w) base += tp_[516 + w];
            if (tid < ne) tp_[tid] = base + x - v;
            if (tid == ne - 1) { tp_[ne] = base + x; tp_[257] = ne; }
            __syncthreads();
        }
        tp = tp_; nwg = tp_[ne] * nN_;
    }
    __device__ void build() {
        const int tid = threadIdx.x;
        if (tid < 60) { Unit u; if (compute(tid, u)) { G8_LAS int* t = (G8_LAS int*)tp + 264 + tid * 4; t[0] = u.pm; t[1] = u.pn; t[2] = u.e; t[3] = u.seg; } }
        __syncthreads();
        tabled = true;
    }
    __device__ bool next(int i, Unit& u) const {
        if (!tabled || i >= 60) return compute(i, u);
        const long L = (long)i * G + c; if (L >= nwg) return false;
        const G8_LAS int* t = tp + 264 + i * 4; u.pm = t[0]; u.pn = t[1]; u.e = t[2]; u.seg = t[3]; u.cnt = 0; return true;
    }
    __device__ bool compute(int i, Unit& u) const {
        const long L = (long)i * G + c; if (L >= nwg) return false;
        int wgid = (int)L; { const int q = nwg / NXCD, r = nwg % NXCD, xcd = wgid % NXCD, off = wgid / NXCD; wgid = (xcd < r ? xcd * (q + 1) : r * (q + 1) + (xcd - r) * q) + off; }
        const int tix = wgid / nN; u.pn = wgid % nN;
        int lo = 0, hi = tp[257];
        while (hi - lo > 1) { const int mid = (lo + hi) >> 1; if (tp[mid] <= tix) lo = mid; else hi = mid; }
        u.e = lo; u.pm = tix - tp[lo]; u.seg = seg[e0 + lo]; u.cnt = 0;
        if (pn_major) { const int nt = tp[lo + 1] - tp[lo], j = wgid - tp[lo] * nN; u.pn = j / nt; u.pm = j % nt; }
        return true;
    }
    __device__ __forceinline__ const char* a_ptr(const Unit& u) const { return a_is_h ? A + ((size_t)(u.seg - seg[e0]) + (size_t)u.pm * BM) * K * 2 : A; }
    __device__ __forceinline__ const char* b_ptr(const Unit& u) const { const char* b = u.e < es1 ? Bt + (size_t)u.e * bstride : (u.e < es2 ? Bt1 + (size_t)(u.e - es1) * bstride : Bt2 + (size_t)(u.e - es2) * bstride); return b + (size_t)u.pn * BM * K * 2; }
    __device__ __forceinline__ const int* rows(const Unit& u) const { return list + u.seg + u.pm * BM; }
};

struct EpiMoe1 {
    static constexpr bool PERM = true; static constexpr int MIDK = 0; static constexpr bool PREFETCH = false;
    bf16_t* H; int seg0;
    __device__ __forceinline__ void operator()(const f32x4 (&acc)[2][2][4][2], const Unit& u, int wr, int wc, int fr, int fq) const {
        const size_t row0 = (size_t)(u.seg - seg0) + u.pm * BM + wr * 64 + fr; const int hc = u.pn * 128 + wc * 32 + 8 * fq;
#pragma unroll
        for (int ai = 0; ai < 2; ++ai)
#pragma unroll
            for (int m = 0; m < 4; ++m) { float o[8];
#pragma unroll
                for (int n = 0; n < 2; ++n)
#pragma unroll
                    for (int j = 0; j < 4; ++j) { const float g = acc[ai][0][m][n][j], up = acc[ai][1][m][n][j]; o[n * 4 + j] = g * fsigmoid(g) * up; }
                u32x4 w; w.x = cvt_pk_bf16(o[0], o[1]); w.y = cvt_pk_bf16(o[2], o[3]); w.z = cvt_pk_bf16(o[4], o[5]); w.w = cvt_pk_bf16(o[6], o[7]);
                *(u32x4*)(H + (row0 + ai * HALF + m * 16) * DE + hc) = w; }
    }
};
struct EpiMoe2 {
    static constexpr bool PERM = true; static constexpr int MIDK = 0; static constexpr bool PREFETCH = false;
    unsigned char* Y; const int* list; const float* pg;
    int qv[8]; float gv[8];
    __device__ __forceinline__ void pre(const Unit& u, int wr, int fr) {
        const int r0 = u.pm * BM + wr * 64 + fr;
#pragma unroll
        for (int i = 0; i < 8; ++i) qv[i] = list[u.seg + r0 + (i >> 2) * HALF + (i & 3) * 16];
#pragma unroll
        for (int i = 0; i < 8; ++i) gv[i] = qv[i] < 0 ? 0.f : pg[qv[i]] * 16.f;
    }
    __device__ __forceinline__ void operator()(const f32x4 (&acc)[2][2][4][2], const Unit& u, int wr, int wc, int fr, int fq) {
        pre(u, wr, fr);
        const int col0 = u.pn * BM + wc * 32 + ((fq & 1) ? HALF + 8 * (fq - 1) : 8 * fq);
#pragma unroll
        for (int ai = 0; ai < 2; ++ai)
#pragma unroll
            for (int m = 0; m < 4; ++m) { const int qq = qv[ai * 4 + m]; const float gt = gv[ai * 4 + m];
                u32x2 w0, w1; w0.x = w0.y = w1.x = w1.y = 0u;
#if defined(__HIP_DEVICE_COMPILE__)
                { const f32x4 v0 = acc[ai][0][m][0] * gt, v1 = acc[ai][0][m][1] * gt;
                  w0.x = __builtin_amdgcn_cvt_pk_fp8_f32(v0[0], v0[1], w0.x, false); w0.x = __builtin_amdgcn_cvt_pk_fp8_f32(v0[2], v0[3], w0.x, true);
                  w0.y = __builtin_amdgcn_cvt_pk_fp8_f32(v1[0], v1[1], w0.y, false); w0.y = __builtin_amdgcn_cvt_pk_fp8_f32(v1[2], v1[3], w0.y, true); }
                { const f32x4 v0 = acc[ai][1][m][0] * gt, v1 = acc[ai][1][m][1] * gt;
                  w1.x = __builtin_amdgcn_cvt_pk_fp8_f32(v0[0], v0[1], w1.x, false); w1.x = __builtin_amdgcn_cvt_pk_fp8_f32(v0[2], v0[3], w1.x, true);
                  w1.y = __builtin_amdgcn_cvt_pk_fp8_f32(v1[0], v1[1], w1.y, false); w1.y = __builtin_amdgcn_cvt_pk_fp8_f32(v1[2], v1[3], w1.y, true); }
                { const bool od = fq & 1;
                  const unsigned rx = (unsigned)__shfl_xor((int)(od ? w0.x : w1.x), 16), ry = (unsigned)__shfl_xor((int)(od ? w0.y : w1.y), 16);
                  w0.x = od ? rx : w0.x; w1.x = od ? w1.x : rx; w0.y = od ? ry : w0.y; w1.y = od ? w1.y : ry; }
#endif
                if (qq >= 0) { u32x4 o; o.x = w0.x; o.y = w0.y; o.z = w1.x; o.w = w1.y; *(u32x4*)(Y + (size_t)qq * DM + col0) = o; } }
    }
};
}

__device__ __forceinline__ int ph_moe1(CP& p, G8_LAS unsigned char* lds, int e0, int ne) {
    const int* counts = (const int*)(p.ws + WS_CTL + CTL_COUNTS); const int* seg = (const int*)(p.ws + WS_SEG); const int* list = (const int*)(p.ws + WS_LIST);
    g8::MoeOrder S; S.init(p.ws + WS_H2, p.ws + WS_WGU, (size_t)512 * DM * 2, counts, seg, list, (G8_LAS int*)(lds + LDS_TP), DM, 2, e0, ne, gridDim.x, blockIdx.x, false);
    S.pn_major = true; S.Bt1 = (const char*)(p.ws + WS_WGU1A); S.es1 = 128; S.Bt2 = (const char*)(p.ws + WS_WGU1B); S.es2 = 128 + GU1B_FIRST;
    S.build();
    g8::EpiMoe1 E{(bf16_t*)(p.ws + WS_H), seg[e0]};
    g8::gemm_phase<g8::EpiMoe1, g8::MoeOrder, true, true, true>(lds, (G8_LAS unsigned*)(lds + LDS_GSLOT), DM, S, E);
    return S.nwg;
}
__device__ __forceinline__ void ph_moe2(CP& p, G8_LAS unsigned char* lds, int e0, int ne, bool wd1 = false, bool gu1b = false) {
    const int* counts = (const int*)(p.ws + WS_CTL + CTL_COUNTS); const int* seg = (const int*)(p.ws + WS_SEG); const int* list = (const int*)(p.ws + WS_LIST);
    g8::MoeOrder S; S.init(p.ws + WS_H, p.ws + WS_WD, (size_t)DM * DE * 2, counts, seg, list, (G8_LAS int*)(lds + LDS_TP), DE, 4, e0, ne, gridDim.x, blockIdx.x, true);
    S.pn_major = true; S.Bt1 = (const char*)(p.ws + WS_WD1); S.es1 = 128;
    S.build();
    g8::EpiMoe2 E; E.Y = (unsigned char*)(p.ws + WS_Y); E.list = list; E.pg = (const float*)(p.ws + WS_PAIRG);
    g8::gemm_phase<g8::EpiMoe2, g8::MoeOrder, false, true, true>(lds, (G8_LAS unsigned*)(lds + LDS_GSLOT), DE, S, E);
}
__device__ __forceinline__ void d_prep(CP& p, float* lds) {
    const int tid = threadIdx.x, lane = tid & 63, wv = tid >> 6;
    const int gtid = blockIdx.x * NT + tid, gsz = gridDim.x * NT;
    const float* c = p.in[I_C];
    for (int i = tid; i < BATCH * DM; i += NT) lds[i] = siluf_(c[i]);
    __syncthreads();
    float* mod = (float*)(p.ws + WS_MOD);
    const float* wada = p.in[I_WADA]; const float* bada = p.in[I_BADA];
    float* part = lds + BATCH * DM;
    for (int cg = blockIdx.x; cg < 96; cg += gridDim.x) {
        const int j = cg * 64 + lane;
        float acc[BATCH];
#pragma unroll
        for (int b = 0; b < BATCH; ++b) acc[b] = 0.f;
#pragma unroll 8
        for (int k = wv * 128; k < wv * 128 + 128; ++k) { const float w = wada[(size_t)k * 6 * DM + j];
#pragma unroll
            for (int b = 0; b < BATCH; ++b) acc[b] += lds[b * DM + k] * w; }
#pragma unroll
        for (int b = 0; b < BATCH; ++b) part[(wv * BATCH + b) * 64 + lane] = acc[b];
        __syncthreads();
        for (int o = tid; o < BATCH * 64; o += NT) { const int b = o >> 6, l = o & 63; float s = bada[cg * 64 + l];
#pragma unroll
            for (int w = 0; w < 8; ++w) s += part[(w * BATCH + b) * 64 + l];
            mod[b * 6 * DM + cg * 64 + l] = s; }
        __syncthreads();
    }
    float* ab_re = (float*)(p.ws + WS_S5P); float* ab_im = ab_re + 2048; float* bb_re = ab_im + 2048; float* bb_im = bb_re + 32768;
    for (int i = gtid; i < S5_G * S5_N; i += gsz) {
        const int g = i / S5_N;
        const float dt = expf(p.in[I_LOGDT][g]);
        const float lr = p.in[I_LRE][i], li = p.in[I_LIM][i];
        const float mag = expf(lr * dt);
        const float are = mag * cosf(li * dt), aim = mag * sinf(li * dt);
        ab_re[i] = are; ab_im[i] = aim;
        const float den = lr * lr + li * li, nr = are - 1.f;
        const float cre = (nr * lr + aim * li) / den, cim = (aim * lr - nr * li) / den;
        for (int cc = 0; cc < S5_C; ++cc) {
            const float br = p.in[I_BRE][i * S5_C + cc], bi = p.in[I_BIM][i * S5_C + cc];
            bb_re[i * S5_C + cc] = cre * br - cim * bi;
            bb_im[i * S5_C + cc] = cre * bi + cim * br;
        }
    }
    int* list = (int*)(p.ws + WS_LIST);
    for (size_t i = gtid; i < LIST_ENTRIES; i += gsz) list[i] = -1;
    __syncthreads();
}

__device__ __forceinline__ void d_hnorm(CP& p) {
    const int lane = threadIdx.x & 63, gw = (blockIdx.x * NT + threadIdx.x) >> 6, nw = gridDim.x * NT / 64;
    const float* x = p.in[I_X]; const float* g = p.in[I_GMIX]; const float* mod = (const float*)(p.ws + WS_MOD);
    bf16_t* hb = (bf16_t*)(p.ws + WS_HBUF);
    for (int r = gw; r < T; r += nw) {
        const int b = r / SEQ;
        float4 v[4]; float ss = 0.f;
#pragma unroll
        for (int j = 0; j < 4; ++j) { v[j] = *(const float4*)(x + (size_t)r * DM + (j >> 1) * 512 + lane * 8 + (j & 1) * 4); ss += v[j].x * v[j].x + v[j].y * v[j].y + v[j].z * v[j].z + v[j].w * v[j].w; }
        const float rstd = rsqrtf(wave_sum(ss) / DM + EPS);
#pragma unroll
        for (int jj = 0; jj < 2; ++jj) { uint4 o; unsigned ow[4];
#pragma unroll
            for (int q = 0; q < 2; ++q) { const int j = jj * 2 + q, c0 = jj * 512 + lane * 8 + q * 4;
                const float4 gg = *(const float4*)(g + c0), sc = *(const float4*)(mod + b * 6 * DM + DM + c0), sh = *(const float4*)(mod + b * 6 * DM + c0);
                const float h0 = (v[j].x * rstd) * gg.x * (1.f + sc.x) + sh.x, h1 = (v[j].y * rstd) * gg.y * (1.f + sc.y) + sh.y;
                const float h2 = (v[j].z * rstd) * gg.z * (1.f + sc.z) + sh.z, h3 = (v[j].w * rstd) * gg.w * (1.f + sc.w) + sh.w;
                ow[2 * q] = (unsigned)f2bf(h0) | ((unsigned)f2bf(h1) << 16); ow[2 * q + 1] = (unsigned)f2bf(h2) | ((unsigned)f2bf(h3) << 16); }
            o.x = ow[0]; o.y = ow[1]; o.z = ow[2]; o.w = ow[3];
            *(uint4*)(hb + (size_t)r * DM + jj * 512 + lane * 8) = o; }
    }
}

__device__ __forceinline__ void d_s5(CP& p, int blk, int nblk) {
    const int lane = threadIdx.x & 63, wv = threadIdx.x >> 6;
    const bf16_t* proj = (const bf16_t*)(p.ws + WS_PROJ); bf16_t* gb = (bf16_t*)(p.ws + WS_GBUF);
    const float* ab_re = (const float*)(p.ws + WS_S5P); const float* ab_im = ab_re + 2048; const float* bb_re = ab_im + 2048; const float* bb_im = bb_re + 32768;
    for (int item = blk * 8 + wv; item < BATCH * S5_G; item += nblk * 8) {
        const int b = item / S5_G, g = item % S5_G, n = lane;
        const float ar = ab_re[g * 64 + n], ai = ab_im[g * 64 + n];
        float bre[16], bim[16], cre[16], cim[16];
#pragma unroll
        for (int c = 0; c < 16; ++c) { bre[c] = bb_re[(g * 64 + n) * 16 + c]; bim[c] = bb_im[(g * 64 + n) * 16 + c];
            cre[c] = p.in[I_CRE][(g * 16 + c) * 64 + n]; cim[c] = p.in[I_CIM][(g * 16 + c) * 64 + n]; }
        const float dsk = lane < 16 ? p.in[I_S5D][g * 16 + lane] : 0.f;
        float hr = 0.f, hi = 0.f;
        for (int t = 0; t < SEQ; ++t) {
            const size_t row = (size_t)b * SEQ + t;
            const float uval = lane < 16 ? bf2f(proj[row * 2048 + g * 16 + lane]) : 0.f;
            float bur = 0.f, bui = 0.f;
#pragma unroll
            for (int c = 0; c < 16; ++c) { const float uc = __shfl(uval, c); bur += uc * bre[c]; bui += uc * bim[c]; }
            const float nhr = ar * hr - ai * hi + bur, nhi = ar * hi + ai * hr + bui;
            hr = nhr; hi = nhi;
            float yv = 0.f;
#pragma unroll
            for (int c = 0; c < 16; ++c) { const float s = wave_sum(cre[c] * hr - cim[c] * hi); if (lane == c) yv = s; }
            if (lane < 16) { const float y = yv + dsk * uval; gb[row * 512 + g * 16 + lane] = f2bf(gelu_tanh(y)); }
        }
    }
}

__device__ __forceinline__ void d_gla(CP& p, int blk, int nblk, float* lds) {
    float* sa = lds; float* sk = lds + 64; float* sq = lds + 128; float* sv = lds + 192; float* so = lds + 320; float* sred = lds + 832;
    const int tid = threadIdx.x, dv = tid & 127, qd = tid >> 7;
    const bf16_t* proj = (const bf16_t*)(p.ws + WS_PROJ); const float* loga = (const float*)(p.ws + WS_LOGA);
    bf16_t* mix = (bf16_t*)(p.ws + WS_MIX);
    for (int item = blk; item < BATCH * GLA_H; item += nblk) {
        const int b = item / GLA_H, h = item % GLA_H;
        float S[16];
#pragma unroll
        for (int i = 0; i < 16; ++i) S[i] = 0.f;
        for (int t = 0; t < SEQ; ++t) {
            const size_t row = (size_t)b * SEQ + t;
            if (tid < 64) { sa[tid] = expf(loga[row * 256 + h * 64 + tid]); sq[tid] = bf2f(proj[row * 2048 + 512 + h * 64 + tid]); sk[tid] = bf2f(proj[row * 2048 + 768 + h * 64 + tid]); }
            else if (tid < 192) sv[tid - 64] = bf2f(proj[row * 2048 + 1024 + h * 128 + (tid - 64)]);
            __syncthreads();
            float part = 0.f; const float vv = sv[dv];
#pragma unroll
            for (int i = 0; i < 16; ++i) { const int kk = qd * 16 + i; S[i] = sa[kk] * S[i] + sk[kk] * vv; part += sq[kk] * S[i]; }
            so[qd * 128 + dv] = part;
            __syncthreads();
            float o = 0.f;
            if (tid < 128) { o = (so[dv] + so[128 + dv] + so[256 + dv] + so[384 + dv]) * 0.125f; const float ssq = wave_sum(o * o); if ((tid & 63) == 0) sred[tid >> 6] = ssq; }
            __syncthreads();
            if (tid < 128) { const float ms = (sred[0] + sred[1]) / 128.f; const float r = bf2f(proj[row * 2048 + 1536 + h * 128 + dv]);
                const float y = o * rsqrtf(ms + EPS) * p.in[I_GLANG][dv] * siluf_(r); mix[row * DM + 512 + h * 128 + dv] = f2bf(y); }
        }
        __syncthreads();
    }
}

__device__ __forceinline__ void d_h2(CP& p) {
    const int lane = threadIdx.x & 63, gw = (blockIdx.x * NT + threadIdx.x) >> 6, nw = gridDim.x * NT / 64;
    const float* g = p.in[I_GMOE]; const float* mod = (const float*)(p.ws + WS_MOD); const float* rowss2 = (const float*)(p.ws + WS_RSS2);
    bf16_t* h2 = (bf16_t*)(p.ws + WS_H2);
    for (int r = gw; r < T; r += nw) {
        const int b = r / SEQ; float ssq = 0.f;
#pragma unroll
        for (int i = 0; i < 4; ++i) { const float4 q4 = *(const float4*)(rowss2 + (size_t)i * (T * 4) + (size_t)r * 4); ssq += q4.x; ssq += q4.y; ssq += q4.z; ssq += q4.w; }
        const float rstd = rsqrtf(ssq / DM + EPS);
#pragma unroll
        for (int jj = 0; jj < 2; ++jj) { const int cb = jj * 512 + lane * 8;
            const uint4 xw4 = *(const uint4*)((const bf16_t*)(p.ws + WS_X1B) + (size_t)r * DM + cb);
            const unsigned xw[4] = {xw4.x, xw4.y, xw4.z, xw4.w}; unsigned ow[4];
#pragma unroll
            for (int q = 0; q < 2; ++q) { const int c0 = cb + q * 4;
                float4 v; v.x = __uint_as_float(xw[2 * q] << 16); v.y = __uint_as_float(xw[2 * q] & 0xffff0000u); v.z = __uint_as_float(xw[2 * q + 1] << 16); v.w = __uint_as_float(xw[2 * q + 1] & 0xffff0000u);
                const float4 gg = *(const float4*)(g + c0), sc = *(const float4*)(mod + b * 6 * DM + 4 * DM + c0), sh = *(const float4*)(mod + b * 6 * DM + 3 * DM + c0);
                const float h0 = (v.x * rstd) * gg.x * (1.f + sc.x) + sh.x, h1 = (v.y * rstd) * gg.y * (1.f + sc.y) + sh.y;
                const float h2v = (v.z * rstd) * gg.z * (1.f + sc.z) + sh.z, h3 = (v.w * rstd) * gg.w * (1.f + sc.w) + sh.w;
                ow[2 * q] = (unsigned)f2bf(h0) | ((unsigned)f2bf(h1) << 16); ow[2 * q + 1] = (unsigned)f2bf(h2v) | ((unsigned)f2bf(h3) << 16); }
            uint4 o; o.x = ow[0]; o.y = ow[1]; o.z = ow[2]; o.w = ow[3];
            *(uint4*)(h2 + (size_t)r * DM + cb) = o; }
    }
}

__device__ __forceinline__ float rt_sigmoid(float x) { return 1.f / (1.f + __expf(-x)); }
__device__ __forceinline__ void rt_ins8(float (&L)[8], int (&I)[8], float v, int id) {
#pragma unroll
    for (int s = 0; s < 8; ++s) { const bool gt = v > L[s]; const float tv = gt ? L[s] : v; const int ti = gt ? I[s] : id; L[s] = gt ? v : L[s]; I[s] = gt ? id : I[s]; v = tv; id = ti; }
}
__device__ __forceinline__ void d_route(CP& p, float* lds, int nrb, bool dry = false) {
    const float* logits = (const float*)(p.ws + WS_LOGITS); const float* rb = p.in[I_RB];
    int* counts = dry ? (int*)(p.ws + WS_H + 4 * MiB) : (int*)(p.ws + WS_CTL + CTL_COUNTS); int* pair_info = (int*)(p.ws + (dry ? WS_H : WS_PAIRI)); float* pair_gate = (float*)(p.ws + (dry ? WS_H + 2 * MiB : WS_PAIRG));
    constexpr int LR = 257;
    int* hist = (int*)(lds + 128 * LR); int* hbase = hist + NE;
    float* gsl = (float*)(hbase + NE);
    const int tk = threadIdx.x >> 2, sub = threadIdx.x & 3;
    for (int t0 = blockIdx.x * 128; t0 < T; t0 += nrb * 128) {
        __syncthreads();
#pragma unroll 4
        for (int i = 0; i < 16; ++i) { const int idx = threadIdx.x + i * NT; const int tkk = idx >> 6, c4 = idx & 63;
            const float4 v = *(const float4*)(logits + (size_t)(t0 + tkk) * 256 + c4 * 4);
            float* d = lds + tkk * LR + c4 * 4; d[0] = v.x; d[1] = v.y; d[2] = v.z; d[3] = v.w; }
        if (threadIdx.x < NE) hist[threadIdx.x] = 0;
        __syncthreads();
        const float* lg = lds + tk * LR;
#pragma unroll
        for (int gg = 0; gg < 2; ++gg) { const int g = 2 * sub + gg; float m1 = -INFINITY, m2 = -INFINITY;
#pragma unroll 8
            for (int i = 0; i < 32; ++i) { const float b0 = rt_sigmoid(lg[g * 32 + i]) + rb[g * 32 + i]; m2 = fmaxf(m2, fminf(m1, b0)); m1 = fmaxf(m1, b0); }
            gsl[tk * 8 + g] = m1 + m2; }
        __syncthreads();
        float gs[8];
#pragma unroll
        for (int g = 0; g < 8; ++g) gs[g] = gsl[tk * 8 + g];
        unsigned selmask = 0u;
#pragma unroll
        for (int a = 0; a < 8; ++a) { int rank = 0;
#pragma unroll
            for (int c = 0; c < 8; ++c) rank += (gs[c] > gs[a] || (gs[c] == gs[a] && c < a)) ? 1 : 0;
            if (rank < 4) selmask |= 1u << a; }
        unsigned rem = selmask;
        for (int k = 0; k < sub; ++k) rem &= rem - 1u;
        const int g = __builtin_ctz(rem);
        float L[8]; int I[8];
#pragma unroll
        for (int s = 0; s < 8; ++s) { L[s] = -INFINITY; I[s] = 0; }
#pragma unroll 4
        for (int i = 0; i < 32; ++i) rt_ins8(L, I, rt_sigmoid(lg[g * 32 + i]) + rb[g * 32 + i], g * 32 + i);
        const unsigned uns = (~selmask) & 0xffu; const int u0 = __builtin_ctz(uns), u1 = __builtin_ctz(uns & (uns - 1u));
        float* park = lds + tk * LR;
        { float* d = park + (sub < 2 ? u0 : u1) * 32 + (sub & 1) * 16;
#pragma unroll
          for (int s = 0; s < 8; ++s) { d[s] = L[s]; d[8 + s] = __int_as_float(I[s]); } }
        __syncthreads();
        float sc[8]; int lrank[8]; float inv = 0.f;
        if (sub == 0) {
#pragma unroll 1
            for (int q = 1; q < 4; ++q) { const float* d = park + (q < 2 ? u0 : u1) * 32 + (q & 1) * 16;
#pragma unroll
                for (int s = 0; s < 8; ++s) rt_ins8(L, I, d[s], __float_as_int(d[8 + s])); }
            float ssum = 0.f;
#pragma unroll
            for (int s = 0; s < 8; ++s) { sc[s] = rt_sigmoid(lg[I[s]]); ssum += sc[s]; }
            inv = ROUTED_SCALE / ssum;
#pragma unroll
            for (int s = 0; s < 8; ++s) lrank[s] = atomicAdd(&hist[I[s]], 1);
        }
        __syncthreads();
        if (threadIdx.x < NE) { const int c = hist[threadIdx.x]; hbase[threadIdx.x] = c ? atomicAdd(&counts[threadIdx.x * CNT_STRIDE], c) : 0; }
        __syncthreads();
        if (sub == 0) { const int t = t0 + tk;
#pragma unroll
            for (int s = 0; s < 8; ++s) { const int rank = hbase[I[s]] + lrank[s]; pair_info[t * 8 + s] = I[s] | (rank << 8); pair_gate[t * 8 + s] = sc[s] * inv; } }
    }
    __syncthreads();
}
__device__ __forceinline__ void d_seglist(CP& p, int* seg_lds) {
    const int* counts = (const int*)(p.ws + WS_CTL + CTL_COUNTS); int* seg = (int*)(p.ws + WS_SEG);
    {
        const int tid = threadIdx.x, ln = tid & 63;
        const int v = tid < NE ? (counts[tid * CNT_STRIDE] + 255) / 256 * 256 : 0; int x = v;
#pragma unroll
        for (int o = 1; o < 64; o <<= 1) { const int y = __shfl_up(x, o); if (ln >= o) x += y; }
        if (ln == 63) seg_lds[516 + (tid >> 6)] = x;
        __syncthreads();
        int base = 0;
        for (int w = 0; w < (tid >> 6); ++w) base += seg_lds[516 + w];
        if (tid < NE) seg_lds[tid] = base + x - v;
        if (tid == NE - 1) seg_lds[NE] = base + x;
        __syncthreads();
    }
    if (blockIdx.x == 0) for (int e = threadIdx.x; e <= NE; e += NT) seg[e] = seg_lds[e];
    const int* pi = (const int*)(p.ws + WS_PAIRI); int* list = (int*)(p.ws + WS_LIST);
    for (int q = blockIdx.x * NT + threadIdx.x; q < NPAIR; q += gridDim.x * NT) { const int v = pi[q]; __hip_atomic_store(&list[seg_lds[v & 255] + (v >> 8)], q, __ATOMIC_RELAXED, __HIP_MEMORY_SCOPE_AGENT); }
    __syncthreads();
}

__device__ __forceinline__ void d_final(CP& p, bool dry = false) {
    const int lane = threadIdx.x & 63, gw = (blockIdx.x * NT + threadIdx.x) >> 6, nw = gridDim.x * NT / 64;
    const unsigned char* Y = (const unsigned char*)(p.ws + WS_Y); const unsigned char* Ys = (const unsigned char*)(p.ws + WS_YSH); const float* mod = (const float*)(p.ws + WS_MOD); const float* gf = p.in[I_GFIN];
    for (int r = gw; r < T; r += nw) {
        const int b = r / SEQ;
        float v[16]; float ss = 0.f;
#pragma unroll
        for (int j = 0; j < 2; ++j) { const int c0 = j * 512 + lane * 8;
            float y[8];
#pragma unroll
            for (int i = 0; i < 8; ++i) y[i] = 0.f;
            float yr[8];
#pragma unroll
            for (int i = 0; i < 8; ++i) yr[i] = 0.f;
#if defined(__HIP_DEVICE_COMPILE__)
#pragma unroll
            for (int k = 0; k < 9; ++k) { const uint2 w = *(const uint2*)(k < 8 ? Y + ((size_t)r * 8 + k) * DM + c0 : Ys + (size_t)r * DM + c0);
              const auto a0 = __builtin_amdgcn_cvt_pk_f32_fp8(w.x, false), a1 = __builtin_amdgcn_cvt_pk_f32_fp8(w.x, true), a2 = __builtin_amdgcn_cvt_pk_f32_fp8(w.y, false), a3 = __builtin_amdgcn_cvt_pk_f32_fp8(w.y, true);
              yr[0] += a0[0]; yr[1] += a0[1]; yr[2] += a1[0]; yr[3] += a1[1]; yr[4] += a2[0]; yr[5] += a2[1]; yr[6] += a3[0]; yr[7] += a3[1]; }
#endif
#pragma unroll
            for (int i = 0; i < 8; ++i) y[i] += yr[i] * (1.f / 16.f);
            const uint4 xw = *(const uint4*)((const bf16_t*)(p.ws + WS_X1B) + (size_t)r * DM + c0);
            float4 x0, x1; x0.x = __uint_as_float(xw.x << 16); x0.y = __uint_as_float(xw.x & 0xffff0000u); x0.z = __uint_as_float(xw.y << 16); x0.w = __uint_as_float(xw.y & 0xffff0000u);
            x1.x = __uint_as_float(xw.z << 16); x1.y = __uint_as_float(xw.z & 0xffff0000u); x1.z = __uint_as_float(xw.w << 16); x1.w = __uint_as_float(xw.w & 0xffff0000u);
            const float4 g0 = *(const float4*)(mod + b * 6 * DM + 5 * DM + c0), g1 = *(const float4*)(mod + b * 6 * DM + 5 * DM + c0 + 4);
            v[j * 8 + 0] = x0.x + g0.x * y[0]; v[j * 8 + 1] = x0.y + g0.y * y[1]; v[j * 8 + 2] = x0.z + g0.z * y[2]; v[j * 8 + 3] = x0.w + g0.w * y[3];
            v[j * 8 + 4] = x1.x + g1.x * y[4]; v[j * 8 + 5] = x1.y + g1.y * y[5]; v[j * 8 + 6] = x1.z + g1.z * y[6]; v[j * 8 + 7] = x1.w + g1.w * y[7];
#pragma unroll
            for (int i = 0; i < 8; ++i) ss += v[j * 8 + i] * v[j * 8 + i]; }
        const float rstd = rsqrtf(wave_sum(ss) / DM + EPS);
#pragma unroll
        for (int j = 0; j < 2; ++j) { const int c0 = j * 512 + lane * 8;
            const float4 f0 = *(const float4*)(gf + c0), f1 = *(const float4*)(gf + c0 + 4);
            float4 o0, o1; o0.x = v[j * 8 + 0] * rstd * f0.x; o0.y = v[j * 8 + 1] * rstd * f0.y; o0.z = v[j * 8 + 2] * rstd * f0.z; o0.w = v[j * 8 + 3] * rstd * f0.w;
            o1.x = v[j * 8 + 4] * rstd * f1.x; o1.y = v[j * 8 + 5] * rstd * f1.y; o1.z = v[j * 8 + 6] * rstd * f1.z; o1.w = v[j * 8 + 7] * rstd * f1.w;
            float* dst = dry ? (float*)(p.ws + WS_H) : p.out;
            *(float4*)(dst + (size_t)r * DM + c0) = o0; *(float4*)(dst + (size_t)r * DM + c0 + 4) = o1; }
    }
}
namespace mx {
typedef short bf16x8 __attribute__((ext_vector_type(8)));
typedef short bf16x4 __attribute__((ext_vector_type(4)));
typedef float f32x4 __attribute__((ext_vector_type(4)));
typedef float f32x16 __attribute__((ext_vector_type(16)));
typedef unsigned u32x2 __attribute__((ext_vector_type(2)));
typedef unsigned u32x4 __attribute__((ext_vector_type(4)));
__device__ __forceinline__ unsigned pk2(float lo, float hi) { unsigned r; asm("v_cvt_pk_bf16_f32 %0, %1, %2" : "=v"(r) : "v"(lo), "v"(hi)); return r; }
__device__ __forceinline__ float fast_gelu(float x) { const float u = 0.7978845608028654f * (x + 0.044715f * x * x * x); const float e = __expf(2.f * u); const float th = 1.f - 2.f * __builtin_amdgcn_rcpf(1.f + e); return 0.5f * x * (1.f + th); }
__device__ __forceinline__ float fast_silu(float x) { return x * __builtin_amdgcn_rcpf(1.f + __expf(-x)); }

__device__ __forceinline__ void s5_item(CP& p, int item, G8_LAS unsigned char* wl) {
    const int lane = threadIdx.x & 63, r = lane & 31, hh = lane >> 5, c16 = lane & 15, q16 = lane >> 4;
    const int b = item / S5_G, g = item % S5_G;
    const bf16_t* proj = (const bf16_t*)(p.ws + WS_PROJ); bf16_t* gb = (bf16_t*)(p.ws + WS_GBUF);
    const float* ab_re = (const float*)(p.ws + WS_S5P); const float* ab_im = ab_re + 2048; const float* bb_re = ab_im + 2048; const float* bb_im = bb_re + 32768;
    bf16x8 bbf[4];
#pragma unroll
    for (int j = 0; j < 4; ++j) { const float* src = (j < 2 ? bb_re : bb_im) + ((size_t)(g * 64 + 32 * (j & 1) + r)) * 16 + 8 * hh;
#pragma unroll
        for (int jj = 0; jj < 8; ++jj) bbf[j][jj] = (short)f2bf(src[jj]); }
    bf16x8 cf[4];
#pragma unroll
    for (int s = 0; s < 4; ++s)
#pragma unroll
        for (int jj = 0; jj < 8; ++jj) { const int k = 32 * s + 8 * q16 + jj; const float v = k < 64 ? p.in[I_CRE][(g * 16 + c16) * 64 + k] : -p.in[I_CIM][(g * 16 + c16) * 64 + (k - 64)]; cf[s][jj] = (short)f2bf(v); }
    const float ar = ab_re[g * 64 + lane], ai = ab_im[g * 64 + lane];
    const float dsk = p.in[I_S5D][g * 16 + c16];
    G8_LAS bf16_t* Hl = (G8_LAS bf16_t*)wl; G8_LAS bf16_t* Ul = (G8_LAS bf16_t*)(wl + 32 * 272);
    float hr = 0.f, hi = 0.f;
    const size_t rowb = (size_t)b * SEQ;
    bf16x8 ufrag = *(const bf16x8*)(proj + (rowb + r) * 2048 + g * 16 + 8 * hh);
    unsigned short yout[8];
#pragma unroll
    for (int i = 0; i < 8; ++i) yout[i] = 0;
    for (int ch = 0; ch < SEQ / 32; ++ch) {
        const int t0 = ch * 32;
        const bf16x8 uf = ufrag;
        if (ch + 1 < SEQ / 32) ufrag = *(const bf16x8*)(proj + (rowb + t0 + 32 + r) * 2048 + g * 16 + 8 * hh);
        if (ch > 0) {
#pragma unroll
            for (int tt = 0; tt < 2; ++tt)
#pragma unroll
                for (int rg = 0; rg < 4; ++rg) gb[(rowb + t0 - 32 + 16 * tt + 4 * q16 + rg) * 512 + g * 16 + c16] = yout[tt * 4 + rg]; }
        *(G8_LAS bf16x8*)(Ul + r * 16 + 8 * hh) = uf;
        f32x16 acc[4];
#pragma unroll
        for (int j = 0; j < 4; ++j) { f32x16 z;
#pragma unroll
            for (int i = 0; i < 16; ++i) z[i] = 0.f;
            acc[j] = __builtin_amdgcn_mfma_f32_32x32x16_bf16(uf, bbf[j], z, 0, 0, 0); }
#pragma unroll
        for (int i = 0; i < 16; ++i) {
            { const float a = acc[0][i], bq = acc[1][i]; const float rr = __shfl_xor(hh ? a : bq, 32); acc[0][i] = hh ? rr : a; acc[1][i] = hh ? bq : rr; }
            { const float a = acc[2][i], bq = acc[3][i]; const float rr = __shfl_xor(hh ? a : bq, 32); acc[2][i] = hh ? rr : a; acc[3][i] = hh ? bq : rr; }
        }
#pragma unroll
        for (int t = 0; t < 32; ++t) { const int sel = (t >> 2) & 1, i = (t & 3) + 4 * (t >> 3);
            const float bur = acc[sel][i], bui = acc[2 + sel][i];
            const float nhr = fmaf(ar, hr, fmaf(-ai, hi, bur)), nhi = fmaf(ar, hi, fmaf(ai, hr, bui));
            hr = nhr; hi = nhi;
            const unsigned hp = pk2(hr, hi); Hl[t * 136 + lane] = (bf16_t)hp; Hl[t * 136 + 64 + lane] = (bf16_t)(hp >> 16); }
        f32x4 ya[2];
#pragma unroll
        for (int tt = 0; tt < 2; ++tt) { ya[tt] = (f32x4){0.f, 0.f, 0.f, 0.f};
#pragma unroll
            for (int s = 0; s < 4; ++s) { const bf16x8 af = *(const G8_LAS bf16x8*)(Hl + (16 * tt + c16) * 136 + 32 * s + 8 * q16);
                ya[tt] = __builtin_amdgcn_mfma_f32_16x16x32_bf16(af, cf[s], ya[tt], 0, 0, 0); } }
#pragma unroll
        for (int tt = 0; tt < 2; ++tt)
#pragma unroll
            for (int rg = 0; rg < 4; ++rg) { const int t = 16 * tt + 4 * q16 + rg; const float u = bf2f(Ul[t * 16 + c16]);
                const float y = ya[tt][rg] + dsk * u; yout[tt * 4 + rg] = f2bf(fast_gelu(y)); }
    }
#pragma unroll
    for (int tt = 0; tt < 2; ++tt)
#pragma unroll
        for (int rg = 0; rg < 4; ++rg) gb[(rowb + SEQ - 32 + 16 * tt + 4 * q16 + rg) * 512 + g * 16 + c16] = yout[tt * 4 + rg];
}

constexpr int G_QI = 0, G_KI = 9216, G_P = 18432, G_V = 27648, G_ST = 45056, G_TOT = 63488, G_DEC = 65536, G_RS = 65792, G_R0 = 66816  , G_Y = 101632  , G_END = 119040;
__device__ __forceinline__ bf16x4 tr_read4(unsigned a) {
#if defined(__HIP_DEVICE_COMPILE__)
    return __builtin_amdgcn_ds_read_tr16_b64_v4i16((G8_LAS bf16x4*)(size_t)a);
#else
    return bf16x4{};
#endif
}
__device__ __forceinline__ bf16x8 cat8(bf16x4 a, bf16x4 b) { bf16x8 o; o[0] = a[0]; o[1] = a[1]; o[2] = a[2]; o[3] = a[3]; o[4] = b[0]; o[5] = b[1]; o[6] = b[2]; o[7] = b[3]; return o; }
#define MX_TR_ADDR(base, RSB, ks, col0, t) ((base) + (unsigned)((16 * (ks) + 8 * hh + 4 * (t) + ((lane & 15) >> 2)) * (RSB) + ((col0) + 16 * ((lane >> 4) & 1) + 4 * (lane & 3)) * 2))

__device__ __forceinline__ void gla_item(CP& p, int item, G8_LAS unsigned char* lds) {
    const int tid = threadIdx.x, lane = tid & 63, w = __builtin_amdgcn_readfirstlane(tid >> 6), r = lane & 31, hh = lane >> 5;
    const int b = item / GLA_H, h = item % GLA_H;
    const bf16_t* proj = (const bf16_t*)(p.ws + WS_PROJ); const float* loga = (const float*)(p.ws + WS_LOGA); bf16_t* mix = (bf16_t*)(p.ws + WS_MIX);
    const unsigned lbase = (unsigned)(size_t)lds;
    G8_LAS bf16_t* QI = (G8_LAS bf16_t*)(lds + G_QI); G8_LAS bf16_t* KI = (G8_LAS bf16_t*)(lds + G_KI); G8_LAS bf16_t* Pm = (G8_LAS bf16_t*)(lds + G_P);
    G8_LAS bf16_t* Vm = (G8_LAS bf16_t*)(lds + G_V); G8_LAS bf16_t* ST = (G8_LAS bf16_t*)(lds + G_ST);
    G8_LAS float* TOT = (G8_LAS float*)(lds + G_TOT); G8_LAS float* DEC = (G8_LAS float*)(lds + G_DEC); G8_LAS float* RS = (G8_LAS float*)(lds + G_RS);
    const int c = lane, sg = w;
    const int tv = tid >> 3, vg = tid & 7;
    const int dvt = w & 3, tt = w >> 2;
    const int di = w >> 2, dj = w & 3;
    const int si = (w == 2) ? 1 : 0, ti = (w == 0) ? 0 : 1;
    f32x16 S;
#pragma unroll
    for (int i = 0; i < 16; ++i) S[i] = 0.f;
    for (int i = tid; i < 128 * 72 / 2; i += NT) ((G8_LAS unsigned*)ST)[i] = 0u;
    const size_t rowb = (size_t)b * SEQ;
    struct Stage { float la[8]; u32x4 q16, k16, v0, v1, r0, r1; };
    Stage stA; G8_LAS bf16_t* Yim = (G8_LAS bf16_t*)(lds + G_Y);
    float4 ngc[4];
#pragma unroll
    for (int q4 = 0; q4 < 4; ++q4) ngc[q4] = *(const float4*)(p.in[I_GLANG] + 32 * dvt + 8 * q4 + 4 * hh);
#define MX_LOAD_CHUNK(st, n_) do { const size_t r0_ = rowb + (size_t)(n_) * 64; \
        _Pragma("unroll") for (int i = 0; i < 8; ++i) { const size_t rr = r0_ + sg * 8 + i; st.la[i] = loga[rr * 256 + h * 64 + c]; } \
        st.q16 = *(const u32x4*)(proj + (r0_ + tv) * 2048 + 512 + h * 64 + vg * 8); st.k16 = *(const u32x4*)(proj + (r0_ + tv) * 2048 + 768 + h * 64 + vg * 8); \
        st.v0 = *(const u32x4*)(proj + (r0_ + tv) * 2048 + 1024 + h * 128 + vg * 16); st.v1 = *(const u32x4*)(proj + (r0_ + tv) * 2048 + 1024 + h * 128 + vg * 16 + 8); \
        st.r0 = *(const u32x4*)(proj + (r0_ + tv) * 2048 + 1536 + h * 128 + vg * 16); st.r1 = *(const u32x4*)(proj + (r0_ + tv) * 2048 + 1536 + h * 128 + vg * 16 + 8); } while (0)
    MX_LOAD_CHUNK(stA, 0);
    auto chunk = [&](const int n, Stage& st) __attribute__((always_inline)) {
        const size_t row0 = rowb + (size_t)n * 64;
        G8_LAS bf16_t* Rim = (G8_LAS bf16_t*)(lds + G_R0 + (n & 1) * 17408);
        float cs[8]; { float a = 0.f;
#pragma unroll
            for (int i = 0; i < 8; ++i) { a += st.la[i]; cs[i] = a; } }
        TOT[sg * 64 + c] = cs[7];
        *(G8_LAS u32x4*)(QI + tv * 72 + vg * 8) = st.q16; *(G8_LAS u32x4*)(KI + tv * 72 + vg * 8) = st.k16;
        *(G8_LAS u32x4*)(Vm + tv * 136 + vg * 16) = st.v0; *(G8_LAS u32x4*)(Vm + tv * 136 + vg * 16 + 8) = st.v1;
        *(G8_LAS u32x4*)(Rim + tv * 136 + vg * 16) = st.r0; *(G8_LAS u32x4*)(Rim + tv * 136 + vg * 16 + 8) = st.r1;
        __syncthreads();
        float pre = 0.f, tot = 0.f;
#pragma unroll
        for (int s = 0; s < 8; ++s) { const float tv_ = TOT[s * 64 + c]; tot += tv_; if (s < sg) pre += tv_; }
#pragma unroll
        for (int i = 0; i < 8; ++i) { const float bc = pre + cs[i]; const float e1 = __expf(bc), e2 = __expf(-bc); const int t = sg * 8 + i;
            const unsigned qk = pk2(bf2f(QI[t * 72 + c]) * e1 * 0.125f, bf2f(KI[t * 72 + c]) * e2); QI[t * 72 + c] = (bf16_t)qk; KI[t * 72 + c] = (bf16_t)(qk >> 16); }
        if (sg == 0) DEC[c] = __expf(tot);
        __syncthreads();
        if (n + 1 < SEQ / 64) MX_LOAD_CHUNK(st, n + 1);
        if (n > 0) {
            const u32x4 y0 = *(const G8_LAS u32x4*)(Yim + tv * 136 + vg * 16), y1 = *(const G8_LAS u32x4*)(Yim + tv * 136 + vg * 16 + 8);
            *(u32x4*)(mix + (row0 - 64 + tv) * DM + 512 + h * 128 + vg * 16) = y0; *(u32x4*)(mix + (row0 - 64 + tv) * DM + 512 + h * 128 + vg * 16 + 8) = y1; }
        if (w < 3) {
            f32x16 sc;
#pragma unroll
            for (int i = 0; i < 16; ++i) sc[i] = 0.f;
#pragma unroll
            for (int kk = 0; kk < 4; ++kk) { const bf16x8 af = *(const G8_LAS bf16x8*)(KI + (32 * si + r) * 72 + 16 * kk + 8 * hh); const bf16x8 bf = *(const G8_LAS bf16x8*)(QI + (32 * ti + r) * 72 + 16 * kk + 8 * hh);
                sc = __builtin_amdgcn_mfma_f32_32x32x16_bf16(af, bf, sc, 0, 0, 0); }
            const int tg = 32 * ti + r;
#pragma unroll
            for (int q4 = 0; q4 < 4; ++q4) { const int s0 = 32 * si + 8 * q4 + 4 * hh; float v[4];
#pragma unroll
                for (int j = 0; j < 4; ++j) v[j] = (s0 + j <= tg) ? sc[4 * q4 + j] : 0.f;
                u32x2 o; o.x = pk2(v[0], v[1]); o.y = pk2(v[2], v[3]); *(G8_LAS u32x2*)(Pm + tg * 72 + s0) = o; }
        }
        f32x16 oa;
#pragma unroll
        for (int i = 0; i < 16; ++i) oa[i] = 0.f;
#pragma unroll
        for (int kk = 0; kk < 4; ++kk) { const bf16x8 af = *(const G8_LAS bf16x8*)(ST + (32 * dvt + r) * 72 + 16 * kk + 8 * hh); const bf16x8 bf = *(const G8_LAS bf16x8*)(QI + (32 * tt + r) * 72 + 16 * kk + 8 * hh);
            oa = __builtin_amdgcn_mfma_f32_32x32x16_bf16(af, bf, oa, 0, 0, 0); }
        bf16x4 vb0[4], vb1[4];
        {
            bf16x4 a0[4], a1[4]; bf16x4 (&b0)[4] = vb0; bf16x4 (&b1)[4] = vb1;
#pragma unroll
            for (int ks = 0; ks < 4; ++ks) { a0[ks] = tr_read4(MX_TR_ADDR(lbase + G_KI, 144, ks, 32 * di, 0)); a1[ks] = tr_read4(MX_TR_ADDR(lbase + G_KI, 144, ks, 32 * di, 1));
                b0[ks] = tr_read4(MX_TR_ADDR(lbase + G_V, 272, ks, 32 * dj, 0)); b1[ks] = tr_read4(MX_TR_ADDR(lbase + G_V, 272, ks, 32 * dj, 1)); }
#pragma unroll
            for (int ks = 0; ks < 4; ++ks) S = __builtin_amdgcn_mfma_f32_32x32x16_bf16(cat8(a0[ks], a1[ks]), cat8(b0[ks], b1[ks]), S, 0, 0, 0);
#pragma unroll
            for (int q4 = 0; q4 < 4; ++q4) { const f32x4 d4 = *(const G8_LAS f32x4*)(DEC + 32 * di + 8 * q4 + 4 * hh);
#pragma unroll
                for (int j = 0; j < 4; ++j) S[4 * q4 + j] *= d4[j]; }
        }
        __syncthreads();
        {
            const int nks = tt ? 4 : 2;
            bf16x4 (&a0)[4] = vb0; bf16x4 (&a1)[4] = vb1;
#pragma unroll
            for (int ks = 0; ks < 4; ++ks) if (ks < nks) { const bf16x8 bf = *(const G8_LAS bf16x8*)(Pm + (32 * tt + r) * 72 + 16 * ks + 8 * hh);
                oa = __builtin_amdgcn_mfma_f32_32x32x16_bf16(cat8(a0[ks], a1[ks]), bf, oa, 0, 0, 0); }
        }
#pragma unroll
        for (int q4 = 0; q4 < 4; ++q4) { u32x2 o; o.x = pk2(S[4 * q4], S[4 * q4 + 1]); o.y = pk2(S[4 * q4 + 2], S[4 * q4 + 3]); *(G8_LAS u32x2*)(ST + (32 * dj + r) * 72 + 32 * di + 8 * q4 + 4 * hh) = o; }
        float ssq = 0.f;
#pragma unroll
        for (int i = 0; i < 16; ++i) ssq += oa[i] * oa[i];
        ssq += __shfl_xor(ssq, 32);
        if (hh == 0) RS[(32 * tt + r) * 4 + dvt] = ssq;
        __syncthreads();
        const f32x4 rs4 = *(const G8_LAS f32x4*)(RS + (32 * tt + r) * 4);
        const float rstd = rsqrtf((rs4[0] + rs4[1] + rs4[2] + rs4[3]) * (1.f / 128.f) + EPS);
#pragma unroll
        for (int q4 = 0; q4 < 4; ++q4) { const float4 ng = ngc[q4];
            const u32x2 rgq = *(const G8_LAS u32x2*)(Rim + (32 * tt + r) * 136 + 32 * dvt + 8 * q4 + 4 * hh);
            const float r0 = __uint_as_float(rgq.x << 16), r1 = __uint_as_float(rgq.x & 0xffff0000u), r2 = __uint_as_float(rgq.y << 16), r3 = __uint_as_float(rgq.y & 0xffff0000u);
            const float y0 = oa[4 * q4] * rstd * ng.x * fast_silu(r0), y1 = oa[4 * q4 + 1] * rstd * ng.y * fast_silu(r1), y2 = oa[4 * q4 + 2] * rstd * ng.z * fast_silu(r2), y3 = oa[4 * q4 + 3] * rstd * ng.w * fast_silu(r3);
            u32x2 yo; yo.x = pk2(y0, y1); yo.y = pk2(y2, y3); *(G8_LAS u32x2*)(Yim + (32 * tt + r) * 136 + 32 * dvt + 8 * q4 + 4 * hh) = yo; }
    };
    for (int n2 = 0; n2 < SEQ / 64; ++n2) chunk(n2, stA);
    __syncthreads();
    { const u32x4 y0 = *(const G8_LAS u32x4*)(Yim + tv * 136 + vg * 16), y1 = *(const G8_LAS u32x4*)(Yim + tv * 136 + vg * 16 + 8);
      *(u32x4*)(mix + (rowb + SEQ - 64 + tv) * DM + 512 + h * 128 + vg * 16) = y0; *(u32x4*)(mix + (rowb + SEQ - 64 + tv) * DM + 512 + h * 128 + vg * 16 + 8) = y1; }
    __syncthreads();
#undef MX_LOAD_CHUNK
}
}
#define XB_TMO      128
#define XB_XCNT(j)  (256  + 64 * (j))
#define XB_XSUB(j)  (1280 + 64 * (j))
#define XB_XGEN(j)  (2304 + 64 * (j))
#define XB_TOP      3328
#define XB_TOPGEN   3392
#define XCD_BAR_WORDS 3456
#define XB_SPIN_CAP (1u << 18)
__device__ __forceinline__ unsigned xb_ld(unsigned* p)              { return __hip_atomic_load(p, __ATOMIC_RELAXED, __HIP_MEMORY_SCOPE_AGENT); }
__device__ __forceinline__ unsigned xb_add(unsigned* p, unsigned v) { return __hip_atomic_fetch_add(p, v, __ATOMIC_RELAXED, __HIP_MEMORY_SCOPE_AGENT); }
__device__ __forceinline__ unsigned xb_xcc_id() { return (unsigned)__builtin_amdgcn_s_getreg((3 << 11) | 20) & 0xFu; }
#define XB_SPIN(cond, bar) do { unsigned _sp = 0; while (cond) { __builtin_amdgcn_s_sleep(1); \
    if ((++_sp & 255u) == 0u) { if (xb_ld(&(bar)[XB_TMO])) break; if (_sp > XB_SPIN_CAP) { atomicAdd(&(bar)[XB_TMO], 1u); break; } } } } while (0)
struct XcdBarrier { unsigned* bar; unsigned x; volatile G8_LAS unsigned* st; };
__device__ __forceinline__ XcdBarrier xcd_barrier_post(unsigned* bar, volatile G8_LAS unsigned* st) {
    XcdBarrier b; b.bar = bar; b.x = xb_xcc_id(); b.st = st;
    if (threadIdx.x == 0) (void)xb_add(&bar[XB_XCNT(b.x)], 1u);
    return b;
}
__device__ __forceinline__ void xcd_barrier_complete(unsigned* bar, unsigned x, unsigned& nloc, unsigned& nx) {
    const unsigned G = gridDim.x * gridDim.y * gridDim.z;
    unsigned sum, cnt, mine, sp = 0u;
    for (;;) {
        sum = 0u; cnt = 0u; mine = 0u;
#pragma unroll
        for (unsigned j = 0; j < 16; ++j) { const unsigned c = xb_ld(&bar[XB_XCNT(j)]); sum += c; cnt += (c > 0u) ? 1u : 0u; mine = (j == x) ? c : mine; }
        if (sum == G) break;
        __builtin_amdgcn_s_sleep(1);
        if ((++sp & 255u) == 0u) { if (xb_ld(&bar[XB_TMO])) break; if (sp > XB_SPIN_CAP) { atomicAdd(&bar[XB_TMO], 1u); break; } }
    }
    nloc = mine > 0u ? mine : 1u; nx = cnt > 0u ? cnt : 1u;
}
__device__ __forceinline__ void xcd_barrier(const XcdBarrier& b) {
    asm volatile("s_waitcnt vmcnt(0)" ::: "memory");
    __syncthreads();
    if (threadIdx.x == 0) {
        unsigned* bar = b.bar;
        __builtin_amdgcn_s_waitcnt(0);
        unsigned nloc = b.st[0], nx = b.st[1];
        if (nloc == 0u) { xcd_barrier_complete(bar, b.x, nloc, nx); b.st[0] = nloc; b.st[1] = nx; }
        const unsigned old = xb_add(&bar[XB_XSUB(b.x)], 1u);
        const unsigned gen = old / nloc;
        if (old + 1u == (gen + 1u) * nloc) {
            __builtin_amdgcn_fence(__ATOMIC_RELEASE, "agent");
            asm volatile("s_waitcnt vmcnt(0)" ::: "memory");
            const unsigned og = xb_add(&bar[XB_TOP], 1u);
            const unsigned tg = og / nx;
            if (og + 1u == (tg + 1u) * nx) xb_add(&bar[XB_TOPGEN], 1u);
            else XB_SPIN(xb_ld(&bar[XB_TOPGEN]) == tg, bar);
            __builtin_amdgcn_fence(__ATOMIC_ACQUIRE, "agent");
            xb_add(&bar[XB_XGEN(b.x)], 1u);
            asm volatile("s_waitcnt vmcnt(0)" ::: "memory");
        } else {
            XB_SPIN(xb_ld(&bar[XB_XGEN(b.x)]) == gen, bar);
            __builtin_amdgcn_fence(__ATOMIC_ACQUIRE, "agent");
            asm volatile("s_waitcnt vmcnt(0)" ::: "memory");
        }
    }
    __syncthreads();
}

constexpr int D1_TAIL = 6;
constexpr int GU1A_EARLY = 1920;
constexpr int CONV_SPLIT = 5440;
__device__ __forceinline__ CP& kargs() { CP* q = (CP*)__builtin_amdgcn_kernarg_segment_ptr(); asm volatile("" : "+s"(q)); return *q; }
constexpr int LDS_SEG = LDS_TP + 2304;
constexpr int LDS_MISC = LDS_SEG + 3072;
static_assert(LDS_MISC + 64 <= LDS_TOTAL, "LDS map");

__global__ void __launch_bounds__(NT, 2) mega(P p) {
    extern __shared__ __attribute__((aligned(16))) unsigned char lds_raw[];
    G8_LAS unsigned char* lds = (G8_LAS unsigned char*)lds_raw;
    volatile G8_LAS unsigned* misc = (volatile G8_LAS unsigned*)(lds + LDS_MISC);
    if (threadIdx.x < 16) misc[threadIdx.x] = 0u;
    __syncthreads();
#define PH kargs()
    XcdBarrier bar = xcd_barrier_post((unsigned*)(PH.ws + WS_CTL + CTL_BAR), misc);
    float* ldsf = (float*)lds_raw;
    int* seg_lds = (int*)(lds_raw + LDS_SEG);

    if (blockIdx.x >= 96) { int tid = threadIdx.x; asm volatile("" : "+v"(tid)); const uint4* src = (const uint4*)PH.in[I_EWG] + (size_t)(blockIdx.x - 96) * 26624; unsigned acc_ = 0;
#pragma unroll 4
      for (int i = 0; i < 52; ++i) { const uint4 v = src[i * NT + tid]; acc_ += v.x ^ v.y ^ v.z ^ v.w; }
      asm volatile("" :: "v"(acc_)); }
    d_prep(PH, ldsf);
    conv_small(PH, blockIdx.x, gridDim.x, ldsf);
    xcd_barrier(bar);
    d_hnorm(PH);
    xcd_barrier(bar);
    ph_inproj(PH, lds);
    xcd_barrier(bar);
    if (blockIdx.x < 64) mx::gla_item(PH, blockIdx.x, lds);
    else if (blockIdx.x < 128) { const int wv_ = __builtin_amdgcn_readfirstlane(threadIdx.x >> 6); mx::s5_item(PH, (blockIdx.x - 64) * 8 + wv_, lds + wv_ * 10240);
        __syncthreads(); conv_experts(PH, 0, 128, true, true, blockIdx.x - 64, 64, ldsf, CONV_SPLIT, 1 << 30); }
    else { conv_experts(PH, 0, 128, true, true, blockIdx.x - 128, gridDim.x - 128, ldsf, 0, CONV_SPLIT);
           conv_experts(PH, 128, 128, false, true, blockIdx.x - 128, gridDim.x - 128, ldsf, 0, 1 << 30, true);
           }
    xcd_barrier(bar);
    ph_glu(PH, lds);
    xcd_barrier(bar);
    ph_wout(PH, lds);
    xcd_barrier(bar);
    d_h2(PH);
    xcd_barrier(bar);
    if (blockIdx.x < 192) ph_rs(PH, lds, 192);
    else conv_experts(PH, 128 + GU1B_FIRST, 128 - GU1B_FIRST, true, false, blockIdx.x - 192, gridDim.x - 192, ldsf, 0, 1 << 30, false, true);
    xcd_barrier(bar);
    d_route(PH, ldsf, gridDim.x);
    xcd_barrier(bar);
    d_seglist(PH, seg_lds);
    conv_experts(PH, 128, GU1B_FIRST, true, false, blockIdx.x, gridDim.x, ldsf, 0, 1 << 30, false, false, true);
    ph_sh2(PH, lds);
    xcd_barrier(bar);
    (void)ph_moe1(PH, lds, 0, 256);
    xcd_barrier(bar);
    ph_moe2(PH, lds, 0, 256);
    xcd_barrier(bar);
    d_final(PH);
}

extern "C" void kernel_launch(void* const* d_in, const int* in_sizes, int n_in, void* d_out, int out_size, void* d_ws, size_t ws_size, hipStream_t stream) {
    static int grid = 0;
    if (grid == 0) {
        if (n_in != 31 || ws_size < WS_END || out_size != T * DM) { fprintf(stderr, "kernel_launch: unexpected shapes (n_in %d ws %zu out %d)\n", n_in, ws_size, out_size); grid = -1; return; }
        int dev = 0, cus = 0, per_cu = 0;
        if (hipGetDevice(&dev) != hipSuccess || hipDeviceGetAttribute(&cus, hipDeviceAttributeMultiprocessorCount, dev) != hipSuccess) { grid = -1; return; }
        if (hipFuncSetAttribute((const void*)mega, hipFuncAttributeMaxDynamicSharedMemorySize, LDS_TOTAL) != hipSuccess) { fprintf(stderr, "kernel_launch: hipFuncSetAttribute failed\n"); grid = -1; return; }
        if (hipOccupancyMaxActiveBlocksPerMultiprocessor(&per_cu, (const void*)mega, NT, LDS_TOTAL) != hipSuccess || per_cu < 1) { fprintf(stderr, "kernel_launch: occupancy query says %d blocks/CU\n", per_cu); (void)hipGetLastError(); grid = -1; return; }
        if (cus != 256) { fprintf(stderr, "kernel_launch: built for a 256-CU device (got %d); nothing launched\n", cus); grid = -1; return; }
        grid = cus;
    }
    if (grid < 0) return;
    (void)hipMemsetAsync((char*)d_ws + WS_CTL, 0, 65536, stream);
    P p{};
    for (int i = 0; i < 31; ++i) p.in[i] = (const float*)d_in[i];
    p.out = (float*)d_out; p.ws = (unsigned char*)d_ws;
    hipLaunchKernelGGL(mega, dim3(grid), dim3(NT), LDS_TOTAL, stream, p);
}
```
